# Optimizing an MI355X kernel written in HIP

```python
import math
import jax, jax.numpy as jnp
from jax import lax
import numpy as np

D_MODEL = 1024
BATCH = 32
SEQ = 2048
DEPTH = 1

PLE_DIM = 256
RMS_EPS = 1e-6
ROPE_THETA = 10000.0
RET_HEADS = 8
RET_DK = D_MODEL // RET_HEADS
RET_DV = 2 * RET_DK
RET_CHUNK = 128
RET_QK_W = RET_HEADS * RET_DK
RET_V_W = RET_HEADS * RET_DV
NSA_HEADS = 16
NSA_GROUPS = 2
NSA_HPG = NSA_HEADS // NSA_GROUPS
NSA_DH = 64
NSA_Q_W = NSA_HEADS * NSA_DH
NSA_KV_W = NSA_GROUPS * NSA_DH
NSA_GATE_W = 3 * NSA_HEADS
CMP_LEN = 32
CMP_STRIDE = 16
CMP_HIDDEN = 256
SEL_BLOCK = 64
SEL_TOPN = 8
WINDOW = 512
NSA_QBLOCK = 64
FORCE_SCORE = 1e6
NEG_INF = -1e30
MLP_HIDDEN = 4 * D_MODEL
IN_SPLITS = [RET_QK_W, RET_QK_W, RET_V_W, RET_V_W, NSA_Q_W] + [NSA_KV_W] * 6 + [NSA_GATE_W]
D_IN = sum(IN_SPLITS)

kernel_name = "hybrid_retention_nsa_gated_block"


def rms_norm(x, g):
    x32 = x.astype(jnp.float32)
    y = x32 * lax.rsqrt(jnp.mean(x32 * x32, axis=-1, keepdims=True) + RMS_EPS)
    return (y * g.astype(jnp.float32)).astype(x.dtype)


def rope_tables(positions, dim):
    inv = ROPE_THETA ** (-jnp.arange(0, dim, 2, dtype=jnp.float32) / dim)
    ang = positions.astype(jnp.float32)[..., None] * inv
    return jnp.cos(ang)[:, :, None, :], jnp.sin(ang)[:, :, None, :]


def apply_rope(x, cos, sin):
    x32 = x.astype(jnp.float32)
    x1, x2 = jnp.split(x32, 2, axis=-1)
    return jnp.concatenate([x1 * cos - x2 * sin, x2 * cos + x1 * sin], axis=-1).astype(x.dtype)


def masked_softmax(s, mask, axis):
    s32 = jnp.where(mask, s.astype(jnp.float32), NEG_INF)
    return jax.nn.softmax(s32, axis=axis) * mask


def retention(q, k, v, g, gn_g):
    B, S = q.shape[:2]
    C = RET_CHUNK
    N = S // C
    dt = q.dtype
    log_g = jnp.log(1.0 - 2.0 ** (-5.0 - jnp.arange(RET_HEADS, dtype=jnp.float32)))
    idx = jnp.arange(C, dtype=jnp.float32)
    diff = idx[:, None] - idx[None, :]
    decay = jnp.where(diff >= 0, jnp.exp(jnp.maximum(diff, 0.0)[None] * log_g[:, None, None]), 0.0).astype(dt)
    xi = jnp.exp((idx + 1.0)[None] * log_g[:, None]).astype(dt)
    zeta = jnp.exp((C - 1.0 - idx)[None] * log_g[:, None]).astype(dt)
    g_chunk = jnp.exp(C * log_g).astype(dt)
    k = k * (RET_DK ** -0.5)

    def chunks(t, d):
        return t.reshape(B, N, C, RET_HEADS, d).transpose(1, 0, 3, 2, 4)

    qc = chunks(q, RET_DK)
    kc = chunks(k, RET_DK)
    vc = chunks(v.reshape(B, S, RET_HEADS, RET_DV), RET_DV)

    def step(R, inp):
        qi, ki, vi = inp
        inner = jnp.einsum('bhnd,bhmd->bhnm', qi, ki) * decay[None]
        o = (jnp.einsum('bhnm,bhme->bhne', inner, vi)
             + jnp.einsum('bhnd,bhde->bhne', qi, R) * xi[None, :, :, None])
        R = g_chunk[None, :, None, None] * R + jnp.einsum('bhmd,bhme->bhde', ki * zeta[None, :, :, None], vi)
        return R, o

    R0 = jnp.zeros((B, RET_HEADS, RET_DK, RET_DV), dt)
    _, o = lax.scan(step, R0, (qc, kc, vc))
    o32 = o.transpose(1, 0, 3, 2, 4).reshape(B, S, RET_HEADS, RET_DV).astype(jnp.float32)
    mu = jnp.mean(o32, axis=-1, keepdims=True)
    var = jnp.mean(jnp.square(o32 - mu), axis=-1, keepdims=True)
    o32 = ((o32 - mu) * lax.rsqrt(var + RMS_EPS)).reshape(B, S, RET_V_W) * gn_g.astype(jnp.float32)
    return (o32 * jax.nn.silu(g.astype(jnp.float32))).astype(dt)


def compress(k, pe, w1, w2):
    S = k.shape[2]
    n_cmp = (S - CMP_LEN) // CMP_STRIDE + 1
    idx = jnp.arange(n_cmp)[:, None] * CMP_STRIDE + jnp.arange(CMP_LEN)[None, :]
    blk = k[:, :, idx] + pe
    blk = blk.reshape(blk.shape[0], blk.shape[1], n_cmp, CMP_LEN * NSA_DH)
    return jax.nn.gelu(blk @ w1) @ w2


def nsa(q, k_cmp, v_cmp, k_sel, v_sel, k_win, v_win, gates,
        cmp_pe_k, cmp_k_w1, cmp_k_w2, cmp_pe_v, cmp_v_w1, cmp_v_w2):
    B, S = q.shape[:2]
    dt = q.dtype
    G, Hg, dh, QB = NSA_GROUPS, NSA_HPG, NSA_DH, NSA_QBLOCK
    scale = dh ** -0.5
    qg = q.reshape(B, S, G, Hg, dh).transpose(0, 2, 3, 1, 4)
    tr = lambda t: t.transpose(0, 2, 1, 3)
    Kc = compress(tr(k_cmp), cmp_pe_k, cmp_k_w1, cmp_k_w2)
    Vc = compress(tr(v_cmp), cmp_pe_v, cmp_v_w1, cmp_v_w2)
    n_cmp = Kc.shape[2]
    c_start = jnp.arange(n_cmp) * CMP_STRIDE
    c_end = c_start + CMP_LEN - 1
    n_blk = S // SEL_BLOCK
    b_start = jnp.arange(n_blk) * SEL_BLOCK
    overlap = ((c_start[:, None] < b_start[None, :] + SEL_BLOCK)
               & (c_end[:, None] >= b_start[None, :])).astype(jnp.float32)
    n_sel = min(SEL_TOPN, n_blk)
    ks_blocks = tr(k_sel).reshape(B, G, n_blk, SEL_BLOCK, dh)
    vs_blocks = tr(v_sel).reshape(B, G, n_blk, SEL_BLOCK, dh)
    pad = ((0, 0), (0, 0), (WINDOW, 0), (0, 0))
    kw_pad = jnp.pad(tr(k_win), pad)
    vw_pad = jnp.pad(tr(v_win), pad)
    n_qb = S // QB
    q_blocks = qg.reshape(B, G, Hg, n_qb, QB, dh).transpose(3, 0, 1, 2, 4, 5)
    g_blocks = jax.nn.sigmoid(gates).reshape(B, n_qb, QB, 3, G, Hg).transpose(1, 3, 0, 4, 5, 2)
    bi = jnp.arange(B)[:, None, None, None]
    gi = jnp.arange(G)[None, :, None, None]
    blk_ids = jnp.arange(n_blk)

    def block_fn(inp):
        qb, gb, qi = inp
        t = qi * QB + jnp.arange(QB)
        s_c = jnp.einsum('bghqd,bgcd->bghqc', qb, Kc) * scale
        p_c = masked_softmax(s_c, c_end[None, :] <= t[:, None], -1)
        o_c = jnp.einsum('bghqc,bgcd->bghqd', p_c.astype(dt), Vc)
        imp = jnp.einsum('bgqc,cn->bgqn', p_c.sum(axis=2), overlap)
        cur = t // SEL_BLOCK
        forced = ((blk_ids[None] == 0) | (blk_ids[None] == cur[:, None])
                  | (blk_ids[None] == cur[:, None] - 1))
        valid = blk_ids[None] <= cur[:, None]
        score = jnp.where(forced, FORCE_SCORE, jnp.where(valid, imp, -1.0))
        _, sel = lax.top_k(score, n_sel)
        k_g = ks_blocks[bi, gi, sel]
        v_g = vs_blocks[bi, gi, sel]
        kpos = sel[..., None] * SEL_BLOCK + jnp.arange(SEL_BLOCK)
        s_mask = (kpos <= t[None, None, :, None, None])[:, :, None]
        s_s = jnp.einsum('bghqd,bgqnkd->bghqnk', qb, k_g) * scale
        p_s = masked_softmax(s_s, s_mask, (-2, -1))
        o_s = jnp.einsum('bghqnk,bgqnkd->bghqd', p_s.astype(dt), v_g)
        k_w = lax.dynamic_slice_in_dim(kw_pad, qi * QB, WINDOW + QB, axis=2)
        v_w = lax.dynamic_slice_in_dim(vw_pad, qi * QB, WINDOW + QB, axis=2)
        wpos = qi * QB - WINDOW + jnp.arange(WINDOW + QB)
        w_mask = ((wpos[None] >= 0) & (wpos[None] <= t[:, None])
                  & (wpos[None] > t[:, None] - WINDOW))
        s_w = jnp.einsum('bghqd,bgkd->bghqk', qb, k_w) * scale
        p_w = masked_softmax(s_w, w_mask, -1)
        o_w = jnp.einsum('bghqk,bgkd->bghqd', p_w.astype(dt), v_w)
        return gb[0][..., None] * o_c + gb[1][..., None] * o_s + gb[2][..., None] * o_w

    out = lax.map(block_fn, (q_blocks, g_blocks, jnp.arange(n_qb)))
    return out.transpose(1, 0, 4, 2, 3, 5).reshape(B, S, NSA_Q_W)


def setup_inputs(seed: int = 0) -> dict:
    key = jax.random.key(seed)
    ks = jax.random.split(key, 24)
    nrm = lambda k, shape, fan_in: jax.random.normal(k, shape, jnp.float32) * (fan_in ** -0.5)
    gain = lambda k, shape: 1.0 + 0.02 * jax.random.normal(k, shape, jnp.float32)
    L = DEPTH
    offs = jax.random.randint(ks[2], (BATCH, 1), 0, 1024, dtype=jnp.int32)
    return {
        "x": jax.random.normal(ks[0], (BATCH, SEQ, D_MODEL), jnp.float32),
        "p": jax.random.normal(ks[1], (DEPTH, BATCH, SEQ, PLE_DIM), jnp.float32),
        "positions": offs + jnp.arange(SEQ, dtype=jnp.int32)[None, :],
        "norm_mix_g": gain(ks[3], (L, D_MODEL)),
        "w_in": nrm(ks[4], (L, D_MODEL, D_IN), D_MODEL),
        "ret_gn_g": gain(ks[5], (L, RET_V_W)),
        "w_ret_o": nrm(ks[6], (L, RET_V_W, D_MODEL), RET_V_W),
        "cmp_pe_k": 0.1 * jax.random.normal(ks[7], (L, CMP_LEN, NSA_DH), jnp.float32),
        "cmp_k_w1": nrm(ks[8], (L, CMP_LEN * NSA_DH, CMP_HIDDEN), CMP_LEN * NSA_DH),
        "cmp_k_w2": nrm(ks[9], (L, CMP_HIDDEN, NSA_DH), CMP_HIDDEN),
        "cmp_pe_v": 0.1 * jax.random.normal(ks[10], (L, CMP_LEN, NSA_DH), jnp.float32),
        "cmp_v_w1": nrm(ks[11], (L, CMP_LEN * NSA_DH, CMP_HIDDEN), CMP_LEN * NSA_DH),
        "cmp_v_w2": nrm(ks[12], (L, CMP_HIDDEN, NSA_DH), CMP_HIDDEN),
        "w_nsa_o": nrm(ks[13], (L, NSA_Q_W, D_MODEL), NSA_Q_W),
        "w_merge_gate": nrm(ks[14], (L, D_MODEL, 2 * D_MODEL), D_MODEL),
        "w_out": nrm(ks[15], (L, D_MODEL, D_MODEL), D_MODEL),
        "norm_mlp_g": gain(ks[16], (L, D_MODEL)),
        "w_mlp_up": nrm(ks[17], (L, D_MODEL, MLP_HIDDEN), D_MODEL),
        "w_mlp_down": nrm(ks[18], (L, MLP_HIDDEN, D_MODEL), MLP_HIDDEN),
        "norm_ple_g": gain(ks[19], (L, D_MODEL)),
        "w_ple_gate": nrm(ks[20], (L, D_MODEL, D_MODEL), D_MODEL),
        "w_ple_proj": nrm(ks[21], (L, PLE_DIM, D_MODEL), PLE_DIM),
        "norm_final_g": gain(ks[22], (D_MODEL,)),
    }


def reference(x, p, positions, norm_mix_g, w_in, ret_gn_g, w_ret_o, cmp_pe_k, cmp_k_w1, cmp_k_w2,
              cmp_pe_v, cmp_v_w1, cmp_v_w2, w_nsa_o, w_merge_gate, w_out, norm_mlp_g, w_mlp_up,
              w_mlp_down, norm_ple_g, w_ple_gate, w_ple_proj, norm_final_g):
    B, S, _ = x.shape
    split_points = np.cumsum(IN_SPLITS)[:-1].tolist()
    cos_r, sin_r = rope_tables(positions, RET_DK)
    cos_n, sin_n = rope_tables(positions, NSA_DH)
    for i in range(DEPTH):
        h = rms_norm(x, norm_mix_g[i])
        proj = h @ w_in[i]
        (rq, rk, rv, rg, nq, kc, vc, ksl, vsl, kw, vw, ngate) = jnp.split(proj, split_points, axis=-1)
        rq = apply_rope(rq.reshape(B, S, RET_HEADS, RET_DK), cos_r, sin_r)
        rk = apply_rope(rk.reshape(B, S, RET_HEADS, RET_DK), cos_r, sin_r)
        o_ret = retention(rq, rk, rv, rg, ret_gn_g[i]) @ w_ret_o[i]
        kvr = lambda t: t.reshape(B, S, NSA_GROUPS, NSA_DH)
        nq = apply_rope(nq.reshape(B, S, NSA_HEADS, NSA_DH), cos_n, sin_n)
        kc = apply_rope(kvr(kc), cos_n, sin_n)
        ksl = apply_rope(kvr(ksl), cos_n, sin_n)
        kw = apply_rope(kvr(kw), cos_n, sin_n)
        o_nsa = nsa(nq, kc, kvr(vc), ksl, kvr(vsl), kw, kvr(vw), ngate,
                    cmp_pe_k[i], cmp_k_w1[i], cmp_k_w2[i], cmp_pe_v[i], cmp_v_w1[i], cmp_v_w2[i]) @ w_nsa_o[i]
        g_ret, g_nsa = jnp.split(jax.nn.sigmoid(h @ w_merge_gate[i]), 2, axis=-1)
        x = x + (g_ret * o_ret + g_nsa * o_nsa) @ w_out[i]
        h2 = rms_norm(x, norm_mlp_g[i])
        x = x + jnp.square(jax.nn.relu(h2 @ w_mlp_up[i])) @ w_mlp_down[i]
        x = x + (p[i] @ w_ple_proj[i]) * jax.nn.sigmoid(rms_norm(x, norm_ple_g[i]) @ w_ple_gate[i])
    return rms_norm(x, norm_final_g)
```

```cpp
#include <hip/hip_runtime.h>
#include <hip/hip_cooperative_groups.h>
#include <cstdio>
#include <cstdint>
namespace cg = cooperative_groups;
namespace pg8 {
#define PG8_LAS __attribute__((address_space(3)))
typedef unsigned short bf16_t;
typedef short bf16x8 __attribute__((ext_vector_type(8)));
typedef float f32x4 __attribute__((ext_vector_type(4)));
typedef unsigned u32x4 __attribute__((ext_vector_type(4)));
constexpr int BM = 256, BK = 64, HALF = 128, HTB = HALF * BK * 2  , STAGE_BYTES = 8 * HTB, NXCD = 8, WGM = 8;

__host__ __device__ __forceinline__ int lds_byte(int r, int c) { const int st = (r >> 4) * 2 + (c >> 5), rr = r & 15, cc = c & 31, ob = rr * 64 + cc * 2; return st * 1024 + (ob ^ (((ob >> 9) & 1) << 5)); }
__host__ __device__ __forceinline__ void stage_rc(int b, int& R, int& C) { const int st = b / 1024, sb = b % 1024, swz = sb ^ (((sb >> 9) & 1) << 5); R = (st >> 1) * 16 + swz / 64; C = (st & 1) * 32 + (swz % 64) / 2; }
__host__ __device__ __forceinline__ int perm32(int rho) { const int n = rho >> 4, i = rho & 15; return 8 * (i >> 2) + 4 * n + (i & 3); }

struct Unit { int pm, pn; };
struct Gemm { const bf16_t* A; const bf16_t* Bt; int M, N, K, lda; };

struct StaticOrder {
    int nM, nN, nwg, G, c;
    __host__ __device__ void init(int M, int N, int G_, int c_) { nM = M / BM; nN = N / BM; nwg = nM * nN; G = G_; c = c_; }
    __host__ __device__ bool next(int i, Unit& u) const {
        const long L = (long)i * G + c; if (L >= nwg) return false;
        int wgid = (int)L; { const int q = nwg / NXCD, r = nwg % NXCD, xcd = wgid % NXCD, off = wgid / NXCD; wgid = (xcd < r ? xcd * (q + 1) : r * (q + 1) + (xcd - r) * q) + off; }
        const int nig = WGM * nN, gid = wgid / nig, fm = gid * WGM, gsz = (nM - fm) < WGM ? (nM - fm) : WGM;
        u.pm = fm + ((wgid % nig) % gsz); u.pn = (wgid % nig) / gsz; return true;
    }
    __device__ __forceinline__ void a_ready(const Unit&) const {}
    __device__ __forceinline__ void done(const Unit&) const {}
};

__device__ __forceinline__ unsigned cvt_pk_bf16(float lo, float hi) { unsigned r; asm volatile("v_cvt_pk_bf16_f32 %0, %1, %2" : "=v"(r) : "v"(lo), "v"(hi)); return r; }
typedef float f32x2 __attribute__((ext_vector_type(2)));
template <class Epi, class Sched, bool ALIGN_EPI = false, bool SP2 = false>
__device__ __forceinline__ void gemm_phase(PG8_LAS unsigned char* lds, const Gemm g, const Sched& S, const Epi& E, const int tid) {
    const int wid = __builtin_amdgcn_readfirstlane(tid >> 6), lane = tid & 63, wr = wid >> 2, wc = wid & 3, fr = lane & 15, fq = lane >> 4;
    const int K = g.K, nt = K / BK;
    unsigned voffA[2], voffB[2];
#pragma unroll
    for (int i = 0; i < 2; ++i) { int R, C; stage_rc(tid * 16 + i * 8192, R, C); const int Rb = Epi::PERM ? ((R & ~31) + perm32(R & 31)) : R;
        voffA[i] = (unsigned)(R * g.lda + C) * 2u; voffB[i] = (unsigned)(Rb * K + C) * 2u; }
    const size_t kstep = (size_t)(BK * 2);
    const size_t hstepA = (size_t)HALF * g.lda * 2, hstepB = (size_t)HALF * K * 2;
    const size_t tstepA = 2 * hstepA, tstepB = 2 * hstepB;
    const unsigned ldsw = (unsigned)wid * 1024u;
    const int aoff = lds_byte(wr * 64 + fr, fq * 8), boff = lds_byte(wc * 32 + fr, fq * 8);
#define PG8_SA(b, h) (((b) * 2 + (h)) * HTB)
#define PG8_SB(b, h) ((4 + (b) * 2 + (h)) * HTB)
#define PG8_STAGE(bufoff, gbase, voff) do { _Pragma("unroll") for (int _i = 0; _i < 2; ++_i) \
        __builtin_amdgcn_global_load_lds((const unsigned*)((const char*)(gbase) + (voff)[_i]), (PG8_LAS unsigned*)(lds + (bufoff) + ldsw + _i * 8192), 16, 0, 0); } while (0)
#define PG8_LDA(dst, b, h) do { _Pragma("unroll") for (int m = 0; m < 4; ++m) _Pragma("unroll") for (int k = 0; k < 2; ++k) dst[m][k] = *(const PG8_LAS bf16x8*)(lds + PG8_SA(b, h) + aoff + m * 2048 + k * 1024); } while (0)
#define PG8_LDB(dst, b, h) do { _Pragma("unroll") for (int n = 0; n < 2; ++n) _Pragma("unroll") for (int k = 0; k < 2; ++k) dst[n][k] = *(const PG8_LAS bf16x8*)(lds + PG8_SB(b, h) + boff + n * 2048 + k * 1024); } while (0)
#define PG8_MMA(ai, bj, At, Bt) do { __builtin_amdgcn_s_setprio(1); _Pragma("unroll") for (int m = 0; m < 4; ++m) _Pragma("unroll") for (int n = 0; n < 2; ++n) _Pragma("unroll") for (int k = 0; k < 2; ++k) \
        acc[ai][bj][m][n] = __builtin_amdgcn_mfma_f32_16x16x32_bf16(Bt[n][k], At[m][k], acc[ai][bj][m][n], 0, 0, 0); __builtin_amdgcn_s_setprio(0); } while (0)
#define PG8_WAIT_V(n) asm volatile("s_waitcnt vmcnt(" #n ")" ::: "memory")
#define PG8_WAIT_L(n) asm volatile("s_waitcnt lgkmcnt(" #n ")" ::: "memory")
#define PG8_BAR __builtin_amdgcn_s_barrier()
#define PG8_SCHED __builtin_amdgcn_sched_barrier(0)
    Unit cur, nxt; int ui = 0;
    if (!S.next(0, cur)) return;
    f32x4 acc[2][2][4][2];
#pragma unroll
    for (int a = 0; a < 2; ++a)
#pragma unroll
        for (int b = 0; b < 2; ++b)
#pragma unroll
            for (int m = 0; m < 4; ++m)
#pragma unroll
                for (int n = 0; n < 2; ++n) acc[a][b][m][n] = (f32x4){0.f, 0.f, 0.f, 0.f};
    bf16x8 At[4][2], B0[2][2], B1[2][2];
    const char* cA = (const char*)g.A + (size_t)cur.pm * tstepA; const char* cB = (const char*)g.Bt + (size_t)cur.pn * tstepB;
    S.a_ready(cur);
    if constexpr (SP2) {
        PG8_STAGE(PG8_SB(0, 0), cB, voffB); PG8_STAGE(PG8_SB(0, 1), cB + hstepB, voffB); PG8_STAGE(PG8_SA(0, 0), cA, voffA); PG8_STAGE(PG8_SA(0, 1), cA + hstepA, voffA);
        if (wr == 1) PG8_BAR;
        PG8_WAIT_V(2); PG8_BAR;
        PG8_STAGE(PG8_SB(1, 0), cB + kstep, voffB); PG8_STAGE(PG8_SA(1, 0), cA + kstep, voffA); PG8_STAGE(PG8_SB(1, 1), cB + hstepB + kstep, voffB);
        PG8_WAIT_V(6); PG8_BAR;
    } else {
        PG8_STAGE(PG8_SB(0, 0), cB, voffB); PG8_STAGE(PG8_SA(0, 0), cA, voffA); PG8_STAGE(PG8_SB(0, 1), cB + hstepB, voffB); PG8_STAGE(PG8_SA(0, 1), cA + hstepA, voffA);
        if (wr == 1) PG8_BAR;
        PG8_WAIT_V(4); PG8_BAR;
        PG8_STAGE(PG8_SB(1, 0), cB + kstep, voffB); PG8_STAGE(PG8_SA(1, 0), cA + kstep, voffA); PG8_STAGE(PG8_SB(1, 1), cB + hstepB + kstep, voffB);
        PG8_WAIT_V(6); PG8_BAR;
    }
    for (;;) {
        const bool has_next = S.next(ui + 1, nxt);
        const char* nA = has_next ? (const char*)g.A + (size_t)nxt.pm * tstepA : cA; const char* nB = has_next ? (const char*)g.Bt + (size_t)nxt.pn * tstepB : cB;
        for (int t = 0; t < nt; t += 2) {
            const bool last = (t == nt - 2);
            const char* a1 = cA + (size_t)(t + 1) * kstep;
            const char* a2 = last ? nA : cA + (size_t)(t + 2) * kstep; const char* b2 = last ? nB : cB + (size_t)(t + 2) * kstep;
            const char* a3 = a2 + kstep; const char* b3 = b2 + kstep;
            if (last && has_next) S.a_ready(nxt);
            if constexpr (SP2) {
            PG8_LDB(B0, 0, 0); PG8_LDB(B1, 0, 1); PG8_SCHED; PG8_LDA(At, 0, 0); PG8_STAGE(PG8_SA(1, 1), a1 + hstepA, voffA);
            PG8_WAIT_V(8); PG8_WAIT_L(0); PG8_BAR; PG8_MMA(0, 0, At, B0); PG8_MMA(0, 1, At, B1); PG8_BAR; PG8_SCHED;
            PG8_LDA(At, 0, 1); PG8_STAGE(PG8_SB(0, 0), b2, voffB); PG8_STAGE(PG8_SB(0, 1), b2 + hstepB, voffB); PG8_STAGE(PG8_SA(0, 0), a2, voffA);
            PG8_WAIT_V(8); PG8_WAIT_L(0); PG8_BAR; PG8_MMA(1, 0, At, B0); PG8_MMA(1, 1, At, B1); PG8_BAR; PG8_SCHED;
            PG8_LDB(B0, 1, 0); PG8_LDB(B1, 1, 1); PG8_SCHED; PG8_LDA(At, 1, 0); PG8_STAGE(PG8_SA(0, 1), a2 + hstepA, voffA);
            PG8_WAIT_V(8); PG8_WAIT_L(0); PG8_BAR; PG8_MMA(0, 0, At, B0); PG8_MMA(0, 1, At, B1); PG8_BAR; PG8_SCHED;
            PG8_LDA(At, 1, 1); PG8_STAGE(PG8_SB(1, 0), b3, voffB); PG8_STAGE(PG8_SB(1, 1), b3 + hstepB, voffB); PG8_STAGE(PG8_SA(1, 0), a3, voffA);
            PG8_WAIT_V(8); PG8_WAIT_L(0); PG8_BAR; PG8_MMA(1, 0, At, B0); PG8_MMA(1, 1, At, B1); PG8_BAR; PG8_SCHED;
            } else {
            PG8_LDB(B0, 0, 0); PG8_SCHED; PG8_LDA(At, 0, 0); PG8_STAGE(PG8_SA(1, 1), a1 + hstepA, voffA);
            PG8_WAIT_L(8); PG8_BAR; PG8_WAIT_L(0); PG8_MMA(0, 0, At, B0); PG8_BAR; PG8_SCHED;
            PG8_LDB(B1, 0, 1); PG8_STAGE(PG8_SB(0, 0), b2, voffB);
            PG8_BAR; PG8_WAIT_L(0); PG8_MMA(0, 1, At, B1); PG8_BAR;
            PG8_LDA(At, 0, 1); PG8_STAGE(PG8_SA(0, 0), a2, voffA);
            PG8_BAR; PG8_WAIT_L(0); PG8_MMA(1, 0, At, B0); PG8_BAR; PG8_SCHED;
            PG8_STAGE(PG8_SB(0, 1), b2 + hstepB, voffB);
            PG8_WAIT_V(6); PG8_BAR; PG8_MMA(1, 1, At, B1); PG8_BAR;
            PG8_LDB(B0, 1, 0); PG8_SCHED; PG8_LDA(At, 1, 0); PG8_STAGE(PG8_SA(0, 1), a2 + hstepA, voffA);
            PG8_WAIT_L(8); PG8_BAR; PG8_WAIT_L(0); PG8_MMA(0, 0, At, B0); PG8_BAR; PG8_SCHED;
            PG8_LDB(B1, 1, 1); PG8_STAGE(PG8_SB(1, 0), b3, voffB);
            PG8_BAR; PG8_WAIT_L(0); PG8_MMA(0, 1, At, B1); PG8_BAR;
            PG8_LDA(At, 1, 1); PG8_STAGE(PG8_SA(1, 0), a3, voffA);
            PG8_BAR; PG8_WAIT_L(0); PG8_MMA(1, 0, At, B0); PG8_BAR; PG8_SCHED;
            PG8_STAGE(PG8_SB(1, 1), b3 + hstepB, voffB);
            PG8_WAIT_V(6); PG8_BAR; PG8_MMA(1, 1, At, B1); PG8_BAR;
            }
        }
        if constexpr (ALIGN_EPI) { if (wr == 0) PG8_BAR; }
        if constexpr (!Epi::AFTER_DRAIN) { E(acc, cur, wr, wc, fr, fq); S.done(cur); }
        if (!has_next) break;
#pragma unroll
        for (int a = 0; a < 2; ++a)
#pragma unroll
            for (int b = 0; b < 2; ++b)
#pragma unroll
                for (int m = 0; m < 4; ++m)
#pragma unroll
                    for (int n = 0; n < 2; ++n) acc[a][b][m][n] = (f32x4){0.f, 0.f, 0.f, 0.f};
        cur = nxt; cA = nA; cB = nB; ++ui;
        if constexpr (ALIGN_EPI) { if (wr == 1) PG8_BAR; }
    }
    PG8_WAIT_V(0);
    if constexpr (!ALIGN_EPI) { if (wr == 0) PG8_BAR; }
    PG8_BAR;
    if constexpr (Epi::AFTER_DRAIN) { E.fused(acc, cur, wr, wc, fr, fq, lds, wid, lane); S.done(cur); }
#undef PG8_SA
#undef PG8_SB
#undef PG8_STAGE
#undef PG8_LDA
#undef PG8_LDB
#undef PG8_MMA
#undef PG8_WAIT_V
#undef PG8_WAIT_L
#undef PG8_BAR
#undef PG8_SCHED
}
}

#define DI __device__ __forceinline__
#define LAS __attribute__((address_space(3)))
#define GAS __attribute__((address_space(1)))
typedef unsigned short bf16_t;
typedef short bf16x8 __attribute__((ext_vector_type(8)));
typedef short s16x4 __attribute__((ext_vector_type(4)));
typedef float f32x4 __attribute__((ext_vector_type(4)));
typedef float f32x16 __attribute__((ext_vector_type(16)));
typedef unsigned u32x4 __attribute__((ext_vector_type(4)));
typedef unsigned u32x2 __attribute__((ext_vector_type(2)));

constexpr int BATCH = 32, SEQ = 2048, DM = 1024, MTOK = BATCH * SEQ;
constexpr int HALF_B = 16, MH = HALF_B * SEQ;
constexpr int D_IN = 7984, NCAT = 10240, PLD = NCAT + 128;
constexpr int C_RQ = 0, C_RK = 1024, C_RV = 2048, C_RG = 4096, C_NQ = 6144, C_NG = 7936, C_MG = 8192;
constexpr int FF = 4096, PLE = 256;
constexpr float EPS = 1e-6f;
constexpr float LOG2E = 1.4426950408889634f;

constexpr size_t MiB = 1u << 20;
constexpr size_t WS_CTL = 0, CTL_BYTES = 1 * MiB;
constexpr size_t WS_WCAT = 1 * MiB, WS_WRO = 21 * MiB, WS_WNO = 25 * MiB, WS_WOUT = 27 * MiB, WS_WUP = 29 * MiB, WS_WDN = 37 * MiB,
                 WS_WPG = 45 * MiB, WS_WPP = 47 * MiB, WS_WC1K = 48 * MiB, WS_WC1V = 49 * MiB, WS_WC2K = 50 * MiB, WS_WC2V = 50 * MiB + 128 * 1024,
                 WS_CBIAS = 50 * MiB + 512 * 1024, WS_ROPER = 52 * MiB, WS_ROPEN = 84 * MiB, WS_H = 100 * MiB, WS_PB = 228 * MiB,
                 WS_KV = 260 * MiB, WS_CH = 308 * MiB, WS_KCO = 312 * MiB, WS_VCO = 312 * MiB + 512 * 1024, WS_PROJ = 320 * MiB, WS_END = 968 * MiB;
constexpr size_t WS_SS1 = 64 * 1024, WS_SS2 = 64 * 1024 + 256 * 1024;
constexpr size_t KVBUF = 8 * MiB;

constexpr int LDS_BYTES = 147456;

struct Params { const float* in[23]; float* out; unsigned char* ws; };

DI unsigned f2bf(float f) { unsigned u = __builtin_bit_cast(unsigned, f); return (u + 0x7fffu + ((u >> 16) & 1u)) >> 16; }
typedef float f32x2_t __attribute__((ext_vector_type(2))); typedef __bf16 bf16x2_t __attribute__((ext_vector_type(2)));
DI unsigned pk2(float lo, float hi) { f32x2_t v = {lo, hi}; bf16x2_t b = __builtin_convertvector(v, bf16x2_t); return __builtin_bit_cast(unsigned, b); }
DI float bflo(unsigned u) { return __builtin_bit_cast(float, u << 16); }
DI float bfhi(unsigned u) { return __builtin_bit_cast(float, u & 0xffff0000u); }
DI float bf2f(bf16_t h) { return __builtin_bit_cast(float, (unsigned)h << 16); }
DI float shx(float v, int o, int lane) { return __builtin_bit_cast(float, __builtin_amdgcn_ds_bpermute((lane ^ o) << 2, __builtin_bit_cast(int, v))); }
DI unsigned shxu(unsigned v, int o, int lane) { return (unsigned)__builtin_amdgcn_ds_bpermute((lane ^ o) << 2, (int)v); }
DI float wave_sum(float v, int lane) {
#pragma unroll
    for (int o = 1; o < 64; o <<= 1) v += shx(v, o, lane);
    return v;
}
DI int lane_id_asm() { int l; asm volatile("v_mbcnt_lo_u32_b32 %0, -1, 0\n\tv_mbcnt_hi_u32_b32 %0, -1, %0" : "=v"(l)); return l; }
DI int crow(int i, int h) { return (i & 3) + 8 * (i >> 2) + 4 * h; }
#define MFMA32(a, b, c) __builtin_amdgcn_mfma_f32_32x32x16_bf16((a), (b), (c), 0, 0, 0)
template <int S> DI bf16x8 pack8(const f32x16& x) {
    u32x4 p; p[0] = pk2(x[8 * S + 0], x[8 * S + 1]); p[1] = pk2(x[8 * S + 2], x[8 * S + 3]); p[2] = pk2(x[8 * S + 4], x[8 * S + 5]); p[3] = pk2(x[8 * S + 6], x[8 * S + 7]);
    return __builtin_bit_cast(bf16x8, p);
}
DI bf16x8 lds16(LAS unsigned char* p) { return *(LAS bf16x8*)p; }
DI bf16x8 lds8x2(LAS unsigned char* p) {
    const s16x4 lo = *(LAS s16x4*)p, hi = *(LAS s16x4*)(p + 16);
    return __builtin_shufflevector(lo, hi, 0, 1, 2, 3, 4, 5, 6, 7);
}
DI float sigmoidf_(float x) { return __builtin_amdgcn_rcpf(1.0f + __expf(-x)); }
DI float gelu_tanh(float x) { const float u = 0.7978845608028654f * (x + 0.044715f * x * x * x); const float e = __expf(2.0f * u); const float t = 1.0f - 2.0f * __builtin_amdgcn_rcpf(e + 1.0f); return 0.5f * x * (1.0f + t); }

enum { K_CAT = 0, K_CMP1, K_CMP2, K_GATE, K_RES, K_RELU2, K_SIG, K_MULRES };
struct EpiAll {
    static constexpr bool PERM = true, AFTER_DRAIN = false;
    int kind, half, flag, ldf, ldh, ldg;
    const float* fb; float* fo; const bf16_t* hg; bf16_t* ho; unsigned char* ws; const float* gvec; float* ssout;
    DI void operator()(const pg8::f32x4 (&acc)[2][2][4][2], const pg8::Unit& u, int wr, int wc, int fr, int fq) const {
        asm volatile("" : "+v"(fr), "+v"(fq));
        const int row0 = u.pm * 256 + wr * 64 + fr, cb0 = wc * 32 + 8 * fq;
        if (kind == K_CAT) {
            const int pn = u.pn;
            bf16_t* PROJ = (bf16_t*)(ws + WS_PROJ);
            const float2* RR = (const float2*)(ws + WS_ROPER); const float2* RN = (const float2*)(ws + WS_ROPEN);
#pragma unroll
            for (int ai = 0; ai < 2; ++ai)
#pragma unroll
                for (int m = 0; m < 4; ++m) {
                    const int row = row0 + ai * 128 + m * 16; const size_t tok = (size_t)half * MH + row;
#pragma unroll
                    for (int bj = 0; bj < 2; ++bj) {
                        const pg8::f32x4 v0 = acc[ai][bj][m][0], v1 = acc[ai][bj][m][1];
                        float x[8] = {v0[0], v0[1], v0[2], v0[3], v1[0], v1[1], v1[2], v1[3]};
                        const int cb = bj * 128 + cb0; const int col = pn * 256 + cb;
                        int mode = 0; float sc = 1.f; const float2* tab = nullptr;
                        bf16_t* dst = PROJ + (size_t)row * PLD + col;
                        if (pn < 8) { mode = 1; tab = RR + tok * 64 + ((col & 127) >> 1); sc = (pn >= 4) ? 0.08838834764831845f : 1.f; }
                        else if (pn >= 24 && pn < 28) { mode = 1; tab = RN + tok * 32 + ((col & 63) >> 1); sc = 0.125f * LOG2E; }
                        else if (pn >= 28 && pn < 31) {
                            const int lc = cb0, g = lc >> 6, d = lc & 63, bl = row >> 11, t = row & 2047;
                            bf16_t* buf = (bf16_t*)(ws + WS_KV + (size_t)((pn - 28) * 2 + bj) * KVBUF);
                            dst = buf + ((size_t)(bl * 2 + g) * SEQ + t) * 64 + d;
                            if (bj == 0) { mode = 1; tab = RN + tok * 32 + (d >> 1); }
                        } else if (pn >= 31) mode = 2;
                        if (mode == 1) {
                            const f32x4 t0 = *(GAS const f32x4*)tab, t1 = *(GAS const f32x4*)(tab + 2);
                            const float c[4] = {t0[0], t0[2], t1[0], t1[2]}, s[4] = {t0[1], t0[3], t1[1], t1[3]};
#pragma unroll
                            for (int p = 0; p < 4; ++p) { const float a = x[2 * p], b = x[2 * p + 1]; x[2 * p] = (a * c[p] - b * s[p]) * sc; x[2 * p + 1] = (b * c[p] + a * s[p]) * sc; }
                        } else if (mode == 2) {
#pragma unroll
                            for (int p = 0; p < 8; ++p) x[p] = sigmoidf_(x[p]);
                        }
                        u32x4 w; w[0] = pk2(x[0], x[1]); w[1] = pk2(x[2], x[3]); w[2] = pk2(x[4], x[5]); w[3] = pk2(x[6], x[7]);
                        *(GAS u32x4*)dst = w;
                    }
                    asm volatile("" ::: "memory");
                }
            return;
        }
        float cbias[2][8];
#pragma unroll
        for (int bj = 0; bj < 2; ++bj)
#pragma unroll
            for (int p = 0; p < 8; ++p) cbias[bj][p] = 0.f;
        if (kind == K_CMP1) {
#pragma unroll
            for (int bj = 0; bj < 2; ++bj)
#pragma unroll
                for (int p = 0; p < 8; ++p) { float b = 0.f;
                    for (int r = 0; r < 16; ++r) b += ((GAS const float*)fb)[r * 256 + u.pn * 256 + bj * 128 + cb0 + p];
                    cbias[bj][p] = b; asm volatile("" ::: "memory"); }
        }
#pragma unroll
        for (int ai = 0; ai < 2; ++ai)
#pragma unroll
            for (int m = 0; m < 4; ++m) {
                const int row = row0 + ai * 128 + m * 16;
                float ssq[2] = {0.f, 0.f};
                float rs = 1.f;
                if ((kind == K_RELU2 || kind == K_SIG) && fb) rs = rsqrtf(((GAS const float*)fb)[row] * (1.f / DM) + EPS);
#pragma unroll
                for (int bj = 0; bj < 2; ++bj) {
                    const pg8::f32x4 v0 = acc[ai][bj][m][0], v1 = acc[ai][bj][m][1];
                    float x[8] = {v0[0], v0[1], v0[2], v0[3], v1[0], v1[1], v1[2], v1[3]};
                    const int col = u.pn * 256 + bj * 128 + cb0;
                    if (kind == K_RES) {
                        bf16_t* op = ho + (size_t)row * ldh + col;
                        float b[8];
                        if (fb) { const float* bp = fb + (size_t)row * ldf + col; const f32x4 b0 = *(GAS const f32x4*)bp, b1 = *(GAS const f32x4*)(bp + 4);
                            b[0] = b0[0]; b[1] = b0[1]; b[2] = b0[2]; b[3] = b0[3]; b[4] = b1[0]; b[5] = b1[1]; b[6] = b1[2]; b[7] = b1[3]; }
                        else { const u32x4 ow = *(GAS const u32x4*)op;
                            b[0] = bflo(ow[0]); b[1] = bfhi(ow[0]); b[2] = bflo(ow[1]); b[3] = bfhi(ow[1]); b[4] = bflo(ow[2]); b[5] = bfhi(ow[2]); b[6] = bflo(ow[3]); b[7] = bfhi(ow[3]); }
                        float v[8];
#pragma unroll
                        for (int p = 0; p < 8; ++p) v[p] = b[p] + x[p];
                        u32x4 w; w[0] = pk2(v[0], v[1]); w[1] = pk2(v[2], v[3]); w[2] = pk2(v[4], v[5]); w[3] = pk2(v[6], v[7]);
                        *(GAS u32x4*)op = w;
                        ssq[bj] = ((v[0] * v[0] + v[1] * v[1]) + (v[2] * v[2] + v[3] * v[3])) + ((v[4] * v[4] + v[5] * v[5]) + (v[6] * v[6] + v[7] * v[7]));
                        continue;
                    }
                    if (kind == K_MULRES) {
                        bf16_t* op = ho + (size_t)row * ldh + col;
                        const u32x4 gw = *(GAS const u32x4*)(hg + (size_t)row * ldg + col);
                        const u32x4 ow = *(GAS const u32x4*)op;
                        u32x4 w;
                        w[0] = pk2(bflo(ow[0]) + x[0] * bflo(gw[0]), bfhi(ow[0]) + x[1] * bfhi(gw[0])); w[1] = pk2(bflo(ow[1]) + x[2] * bflo(gw[1]), bfhi(ow[1]) + x[3] * bfhi(gw[1]));
                        w[2] = pk2(bflo(ow[2]) + x[4] * bflo(gw[2]), bfhi(ow[2]) + x[5] * bfhi(gw[2])); w[3] = pk2(bflo(ow[3]) + x[6] * bflo(gw[3]), bfhi(ow[3]) + x[7] * bfhi(gw[3]));
                        *(GAS u32x4*)op = w;
                        continue;
                    }
                    bf16_t* dst = ho + (size_t)row * ldh + col;
                    if (kind == K_CMP1) {
#pragma unroll
                        for (int p = 0; p < 8; ++p) x[p] = gelu_tanh(x[p] + cbias[bj][p]);
                    } else if (kind == K_CMP2) {
                        if (col >= 64) continue;
                    } else if (kind == K_GATE) {
                        const u32x4 gw = *(GAS const u32x4*)(hg + (size_t)row * ldg + col);
                        const float gv[8] = {bflo(gw[0]), bfhi(gw[0]), bflo(gw[1]), bfhi(gw[1]), bflo(gw[2]), bfhi(gw[2]), bflo(gw[3]), bfhi(gw[3])};
#pragma unroll
                        for (int p = 0; p < 8; ++p) x[p] *= gv[p];
                        if (flag) { const u32x4 ow = *(GAS const u32x4*)dst;
                            x[0] += bflo(ow[0]); x[1] += bfhi(ow[0]); x[2] += bflo(ow[1]); x[3] += bfhi(ow[1]); x[4] += bflo(ow[2]); x[5] += bfhi(ow[2]); x[6] += bflo(ow[3]); x[7] += bfhi(ow[3]); }
                    } else if (kind == K_RELU2) {
#pragma unroll
                        for (int p = 0; p < 8; ++p) { const float r = fmaxf(x[p] * rs, 0.f); x[p] = r * r; }
                    } else if (kind == K_SIG) {
#pragma unroll
                        for (int p = 0; p < 8; ++p) x[p] = sigmoidf_(x[p] * rs);
                    }
                    u32x4 w; w[0] = pk2(x[0], x[1]); w[1] = pk2(x[2], x[3]); w[2] = pk2(x[4], x[5]); w[3] = pk2(x[6], x[7]);
                    *(GAS u32x4*)dst = w;
                }
                if (kind == K_RES) {
                    float t = ssq[0] + ssq[1];
                    t += shx(t, 16, fr + 16 * fq); t += shx(t, 32, fr + 16 * fq);
                    if (fq == 0) (void)__hip_atomic_fetch_add((GAS float*)ssout + row, t, __ATOMIC_RELAXED, __HIP_MEMORY_SCOPE_AGENT);
                }
                asm volatile("" ::: "memory");
            }
    }
};
#define XB_TMO      128
#define XB_XCNT(j)  (256  + 64 * (j))
#define XB_XSUB(j)  (1280 + 64 * (j))
#define XB_XGEN(j)  (2304 + 64 * (j))
#define XB_TOP      3328
#define XB_TOPGEN   3392
#define XCD_BAR_WORDS 3456
#define XB_SPIN_CAP (1u << 18)

__device__ __forceinline__ unsigned xb_ld(unsigned* p)              { return __hip_atomic_load(p, __ATOMIC_RELAXED, __HIP_MEMORY_SCOPE_AGENT); }
__device__ __forceinline__ unsigned xb_add(unsigned* p, unsigned v) { return __hip_atomic_fetch_add(p, v, __ATOMIC_RELAXED, __HIP_MEMORY_SCOPE_AGENT); }
__device__ __forceinline__ unsigned xb_xcc_id() { return (unsigned)__builtin_amdgcn_s_getreg((3 << 11) | 20) & 0xFu; }
#define XB_SPIN(cond, bar) do { unsigned _sp = 0; while (cond) { __builtin_amdgcn_s_sleep(1); \
    if ((++_sp & 255u) == 0u) { if (xb_ld(&(bar)[XB_TMO])) break; if (_sp > XB_SPIN_CAP) { atomicAdd(&(bar)[XB_TMO], 1u); break; } } } } while (0)

struct XcdBarrier {
    unsigned* bar; unsigned x;
    volatile LAS unsigned* st;
};

__device__ __forceinline__ XcdBarrier xcd_barrier_post(unsigned* bar, volatile LAS unsigned* st) {
    XcdBarrier b; b.bar = bar; b.x = xb_xcc_id(); b.st = st;
    if (threadIdx.x == 0) (void)xb_add(&bar[XB_XCNT(b.x)], 1u);
    return b;
}
__device__ __forceinline__ void xcd_barrier_complete(unsigned* bar, unsigned x, unsigned& nloc, unsigned& nx) {
    const unsigned G = gridDim.x * gridDim.y * gridDim.z;
    unsigned sum, cnt, mine, sp = 0u;
    for (;;) {
        sum = 0u; cnt = 0u; mine = 0u;
#pragma unroll
        for (unsigned j = 0; j < 16; ++j) { const unsigned c = xb_ld(&bar[XB_XCNT(j)]); sum += c; cnt += (c > 0u) ? 1u : 0u; mine = (j == x) ? c : mine; }
        if (sum == G) break;
        __builtin_amdgcn_s_sleep(1);
        if ((++sp & 255u) == 0u) { if (xb_ld(&bar[XB_TMO])) break; if (sp > XB_SPIN_CAP) { atomicAdd(&bar[XB_TMO], 1u); break; } }
    }
    nloc = mine > 0u ? mine : 1u; nx = cnt > 0u ? cnt : 1u;
}

__device__ __forceinline__ void xcd_barrier(const XcdBarrier& b) {
    asm volatile("s_waitcnt vmcnt(0)" ::: "memory");
    __syncthreads();
    if (threadIdx.x == 0) {
        unsigned* bar = b.bar;
        __builtin_amdgcn_s_waitcnt(0);
        unsigned nloc = b.st[0], nx = b.st[1];
        if (nloc == 0u) { xcd_barrier_complete(bar, b.x, nloc, nx); b.st[0] = nloc; b.st[1] = nx; }
        const unsigned old = xb_add(&bar[XB_XSUB(b.x)], 1u);
        const unsigned gen = old / nloc;
        if (old + 1u == (gen + 1u) * nloc) {
            __builtin_amdgcn_fence(__ATOMIC_RELEASE, "agent");
            asm volatile("s_waitcnt vmcnt(0)" ::: "memory");
            const unsigned og = xb_add(&bar[XB_TOP], 1u);
            const unsigned tg = og / nx;
            if (og + 1u == (tg + 1u) * nx) xb_add(&bar[XB_TOPGEN], 1u);
            else XB_SPIN(xb_ld(&bar[XB_TOPGEN]) == tg, bar);
            __builtin_amdgcn_fence(__ATOMIC_ACQUIRE, "agent");
            xb_add(&bar[XB_XGEN(b.x)], 1u);
            asm volatile("s_waitcnt vmcnt(0)" ::: "memory");
        } else {
            XB_SPIN(xb_ld(&bar[XB_XGEN(b.x)]) == gen, bar);
            __builtin_amdgcn_fence(__ATOMIC_ACQUIRE, "agent");
            asm volatile("s_waitcnt vmcnt(0)" ::: "memory");
        }
    }
    __syncthreads();
}


DI int perm_hs(int n, int hs) { const int j = n & (hs - 1); return (n - j) + (j >> 1) + (j & 1) * (hs >> 1); }
template <int CM> DI int colmap(int n) {
    if (CM == 0) return n;
    if (CM == 1) {
        if (n >= D_IN) return -1;
        if (n < 2048) return perm_hs(n, 128);
        if (n >= 6144 && n < 7296) return perm_hs(n, 64);
        if ((n >= 7424 && n < 7552) || (n >= 7680 && n < 7808)) return perm_hs(n, 64);
        return n;
    }
    if (CM == 2) return n < 64 ? perm_hs(n, 64) : -1;
    return n < 64 ? n : -1;
}
template <int KM> DI int kmap(int k) { if (KM == 0) return k; return perm_hs(k, 64); }
template <int CM, int KM> DI void transpose_item(const float* W, int K, int Nsrc, int nblk, bf16_t* WT, int row_off, LAS float* scr, int item, int lane, const float* kscale = nullptr) {
    const int kb = item / nblk, nb = item % nblk, k0 = 64 * kb, n0 = 32 * nb;
    const int nsrc = colmap<CM>(n0 + (lane & 31));
#pragma unroll 8
    for (int i = 0; i < 32; ++i) { const int kk = 2 * i + (lane >> 5); const int ks = kmap<KM>(k0 + kk); scr[kk * 33 + (lane & 31)] = nsrc >= 0 ? W[(size_t)ks * Nsrc + nsrc] * (kscale ? kscale[ks] : 1.f) : 0.f; }
    asm volatile("s_waitcnt lgkmcnt(0)" ::: "memory");
    const int c = lane & 7;
#pragma unroll
    for (int j = 0; j < 4; ++j) { const int n = (lane >> 3) + 8 * j; const LAS float* s = scr + (8 * c) * 33 + n;
        u32x4 o; o[0] = pk2(s[0 * 33], s[1 * 33]); o[1] = pk2(s[2 * 33], s[3 * 33]); o[2] = pk2(s[4 * 33], s[5 * 33]); o[3] = pk2(s[6 * 33], s[7 * 33]);
        *(GAS u32x4*)(WT + (size_t)(row_off + n0 + n) * K + k0 + 8 * c) = o; }
    asm volatile("s_waitcnt lgkmcnt(0)" ::: "memory");
}
DI void rms_row_bf16(const float* xrow, const float* g, bf16_t* orow, int lane) {
    GAS const f32x4* xr = (GAS const f32x4*)xrow + lane; GAS const f32x4* gr = (GAS const f32x4*)g + lane;
    f32x4 v[4]; float s = 0.f;
#pragma unroll
    for (int j = 0; j < 4; ++j) { v[j] = xr[64 * j]; s += (v[j][0] * v[j][0] + v[j][1] * v[j][1]) + (v[j][2] * v[j][2] + v[j][3] * v[j][3]); }
    const float r = rsqrtf(wave_sum(s, lane) * (1.f / DM) + EPS);
    GAS u32x2* o8 = (GAS u32x2*)orow + lane;
#pragma unroll
    for (int j = 0; j < 4; ++j) { const f32x4 gg = gr[64 * j]; u32x2 w; w[0] = pk2(v[j][0] * r * gg[0], v[j][1] * r * gg[1]); w[1] = pk2(v[j][2] * r * gg[2], v[j][3] * r * gg[3]); o8[64 * j] = w; }
}
DI void rms_row_final(const bf16_t* xrow, const float* g, float* orow, int lane) {
    GAS const u32x2* xr = (GAS const u32x2*)xrow + lane; GAS const f32x4* gr = (GAS const f32x4*)g + lane;
    f32x4 v[4]; float s = 0.f;
#pragma unroll
    for (int j = 0; j < 4; ++j) { const u32x2 w = xr[64 * j]; v[j] = (f32x4){bflo(w[0]), bfhi(w[0]), bflo(w[1]), bfhi(w[1])}; s += (v[j][0] * v[j][0] + v[j][1] * v[j][1]) + (v[j][2] * v[j][2] + v[j][3] * v[j][3]); }
    const float r = rsqrtf(wave_sum(s, lane) * (1.f / DM) + EPS);
    GAS f32x4* o = (GAS f32x4*)orow + lane;
#pragma unroll
    for (int j = 0; j < 4; ++j) { const f32x4 gg = gr[64 * j]; o[64 * j] = (f32x4){v[j][0] * r * gg[0], v[j][1] * r * gg[1], v[j][2] * r * gg[2], v[j][3] * r * gg[3]}; }
}

DI void rms_row2_bf16(const float* x0, const float* x1, const float* g, bf16_t* o0, bf16_t* o1, int lane) {
    GAS const f32x4* xa = (GAS const f32x4*)x0 + lane; GAS const f32x4* xb = (GAS const f32x4*)x1 + lane; GAS const f32x4* gr = (GAS const f32x4*)g + lane;
    f32x4 a[4], b[4]; float sa = 0.f, sb = 0.f;
#pragma unroll
    for (int j = 0; j < 4; ++j) { a[j] = __builtin_nontemporal_load(xa + 64 * j); b[j] = __builtin_nontemporal_load(xb + 64 * j); }
#pragma unroll
    for (int j = 0; j < 4; ++j) { sa += (a[j][0] * a[j][0] + a[j][1] * a[j][1]) + (a[j][2] * a[j][2] + a[j][3] * a[j][3]); sb += (b[j][0] * b[j][0] + b[j][1] * b[j][1]) + (b[j][2] * b[j][2] + b[j][3] * b[j][3]); }
    const float ra = rsqrtf(wave_sum(sa, lane) * (1.f / DM) + EPS), rb = rsqrtf(wave_sum(sb, lane) * (1.f / DM) + EPS);
    GAS u32x2* pa = (GAS u32x2*)o0 + lane; GAS u32x2* pb = (GAS u32x2*)o1 + lane;
#pragma unroll
    for (int j = 0; j < 4; ++j) { const f32x4 gg = gr[64 * j]; u32x2 w;
        w[0] = pk2(a[j][0] * ra * gg[0], a[j][1] * ra * gg[1]); w[1] = pk2(a[j][2] * ra * gg[2], a[j][3] * ra * gg[3]); pa[64 * j] = w;
        w[0] = pk2(b[j][0] * rb * gg[0], b[j][1] * rb * gg[1]); w[1] = pk2(b[j][2] * rb * gg[2], b[j][3] * rb * gg[3]); pb[64 * j] = w; }
}
DI void rms_row2_final(const bf16_t* x0, const bf16_t* x1, const float* g, float* o0, float* o1, int lane) {
    GAS const u32x2* xa = (GAS const u32x2*)x0 + lane; GAS const u32x2* xb = (GAS const u32x2*)x1 + lane; GAS const f32x4* gr = (GAS const f32x4*)g + lane;
    u32x2 wa[4], wb[4]; float sa = 0.f, sb = 0.f;
#pragma unroll
    for (int j = 0; j < 4; ++j) { wa[j] = xa[64 * j]; wb[j] = xb[64 * j]; }
    f32x4 a[4], b[4];
#pragma unroll
    for (int j = 0; j < 4; ++j) { a[j] = (f32x4){bflo(wa[j][0]), bfhi(wa[j][0]), bflo(wa[j][1]), bfhi(wa[j][1])}; b[j] = (f32x4){bflo(wb[j][0]), bfhi(wb[j][0]), bflo(wb[j][1]), bfhi(wb[j][1])};
        sa += (a[j][0] * a[j][0] + a[j][1] * a[j][1]) + (a[j][2] * a[j][2] + a[j][3] * a[j][3]); sb += (b[j][0] * b[j][0] + b[j][1] * b[j][1]) + (b[j][2] * b[j][2] + b[j][3] * b[j][3]); }
    const float ra = rsqrtf(wave_sum(sa, lane) * (1.f / DM) + EPS), rb = rsqrtf(wave_sum(sb, lane) * (1.f / DM) + EPS);
    GAS f32x4* pa = (GAS f32x4*)o0 + lane; GAS f32x4* pb = (GAS f32x4*)o1 + lane;
#pragma unroll
    for (int j = 0; j < 4; ++j) { const f32x4 gg = gr[64 * j];
        __builtin_nontemporal_store((f32x4){a[j][0] * ra * gg[0], a[j][1] * ra * gg[1], a[j][2] * ra * gg[2], a[j][3] * ra * gg[3]}, pa + 64 * j);
        __builtin_nontemporal_store((f32x4){b[j][0] * rb * gg[0], b[j][1] * rb * gg[1], b[j][2] * rb * gg[2], b[j][3] * rb * gg[3]}, pb + 64 * j); }
}

DI float2 rope_cs(float ang) { const float rev = ang * 0.15915494309189535f; const float fr = rev - rintf(rev); return make_float2(__builtin_amdgcn_cosf(fr), __builtin_amdgcn_sinf(fr)); }
DI void prologue(const Params& P, unsigned char* ws, LAS unsigned char* lds, int tid, int lane, int wave) {
    LAS float* scr = (LAS float*)(lds + wave * 16384);
    const int gw = blockIdx.x * 8 + wave, NGW = gridDim.x * 8;
    constexpr int I_CAT1 = 16 * 256, I_CAT2 = 16 * 64, I_RO = 32 * 32, I_NO = 16 * 32, I_OUT = 16 * 32, I_UP = 16 * 128, I_DN = 64 * 32, I_PG = 16 * 32, I_PP = 4 * 32,
                  I_C1 = 32 * 8, I_C2 = 4 * 8;
    constexpr int NIT = I_CAT1 + I_CAT2 + I_RO + I_NO + I_OUT + I_UP + I_DN + I_PG + I_PP + 2 * I_C1 + 2 * I_C2;
    for (int it = gw; it < NIT; it += NGW) {
        int r = it;
        if (r < I_CAT1) { transpose_item<1, 0>(P.in[4], 1024, D_IN, 256, (bf16_t*)(ws + WS_WCAT), 0, scr, r, lane); continue; } r -= I_CAT1;
        if (r < I_CAT2) { transpose_item<0, 0>(P.in[14], 1024, 2048, 64, (bf16_t*)(ws + WS_WCAT), 8192, scr, r, lane); continue; } r -= I_CAT2;
        if (r < I_RO) { transpose_item<0, 0>(P.in[6], 2048, 1024, 32, (bf16_t*)(ws + WS_WRO), 0, scr, r, lane); continue; } r -= I_RO;
        if (r < I_NO) { transpose_item<0, 0>(P.in[13], 1024, 1024, 32, (bf16_t*)(ws + WS_WNO), 0, scr, r, lane); continue; } r -= I_NO;
        if (r < I_OUT) { transpose_item<0, 0>(P.in[15], 1024, 1024, 32, (bf16_t*)(ws + WS_WOUT), 0, scr, r, lane); continue; } r -= I_OUT;
        if (r < I_UP) { transpose_item<0, 0>(P.in[17], 1024, 4096, 128, (bf16_t*)(ws + WS_WUP), 0, scr, r, lane, P.in[16]); continue; } r -= I_UP;
        if (r < I_DN) { transpose_item<0, 0>(P.in[18], 4096, 1024, 32, (bf16_t*)(ws + WS_WDN), 0, scr, r, lane); continue; } r -= I_DN;
        if (r < I_PG) { transpose_item<0, 0>(P.in[20], 1024, 1024, 32, (bf16_t*)(ws + WS_WPG), 0, scr, r, lane, P.in[19]); continue; } r -= I_PG;
        if (r < I_PP) { transpose_item<0, 0>(P.in[21], 256, 1024, 32, (bf16_t*)(ws + WS_WPP), 0, scr, r, lane); continue; } r -= I_PP;
        if (r < I_C1) { transpose_item<0, 1>(P.in[8], 2048, 256, 8, (bf16_t*)(ws + WS_WC1K), 0, scr, r, lane); continue; } r -= I_C1;
        if (r < I_C1) { transpose_item<0, 0>(P.in[11], 2048, 256, 8, (bf16_t*)(ws + WS_WC1V), 0, scr, r, lane); continue; } r -= I_C1;
        if (r < I_C2) { transpose_item<2, 0>(P.in[9], 256, 64, 8, (bf16_t*)(ws + WS_WC2K), 0, scr, r, lane); continue; } r -= I_C2;
        transpose_item<3, 0>(P.in[12], 256, 64, 8, (bf16_t*)(ws + WS_WC2V), 0, scr, r, lane);
    }
    for (int m = gw; m < MTOK; m += 2 * NGW) if (m + NGW >= MTOK) rms_row_bf16(P.in[0] + (size_t)m * DM, P.in[3], (bf16_t*)(ws + WS_H) + (size_t)m * DM, lane); else rms_row2_bf16(P.in[0] + (size_t)m * DM, P.in[0] + (size_t)(m + NGW) * DM, P.in[3], (bf16_t*)(ws + WS_H) + (size_t)m * DM, (bf16_t*)(ws + WS_H) + (size_t)(m + NGW) * DM, lane);
    {
        const size_t n4 = (size_t)MTOK * PLE / 4, gt = (size_t)blockIdx.x * 512 + tid, NT = (size_t)gridDim.x * 512;
        const f32x4* src = (const f32x4*)P.in[1]; u32x2* dst = (u32x2*)(ws + WS_PB);
        size_t i = gt;
        for (; i + 7 * NT < n4; i += 8 * NT) { f32x4 v[8];
#pragma unroll
            for (int k = 0; k < 8; ++k) v[k] = src[i + k * NT];
#pragma unroll
            for (int k = 0; k < 8; ++k) { u32x2 w; w[0] = pk2(v[k][0], v[k][1]); w[1] = pk2(v[k][2], v[k][3]); dst[i + k * NT] = w; } }
        for (; i < n4; i += NT) { const f32x4 v = src[i]; u32x2 w; w[0] = pk2(v[0], v[1]); w[1] = pk2(v[2], v[3]); dst[i] = w; }
        const int* pos = (const int*)P.in[2];
        float2* RR = (float2*)(ws + WS_ROPER); float2* RN = (float2*)(ws + WS_ROPEN);
        i = gt;
        for (; i + 7 * NT < (size_t)MTOK * 64; i += 8 * NT) { int pv[8];
#pragma unroll
            for (int k = 0; k < 8; ++k) pv[k] = pos[(i + k * NT) >> 6];
#pragma unroll
            for (int k = 0; k < 8; ++k) { const int fi = (int)((i + k * NT) & 63); const float inv = __builtin_amdgcn_exp2f(-(float)(2 * fi) * (13.287712379549449f / 128.0f)); const float ang = (float)pv[k] * inv; RR[i + k * NT] = rope_cs(ang); } }
        for (; i < (size_t)MTOK * 64; i += NT) { const int tok = (int)(i >> 6), fi = (int)(i & 63);
            const float inv = __builtin_amdgcn_exp2f(-(float)(2 * fi) * (13.287712379549449f / 128.0f)); const float ang = (float)pos[tok] * inv; RR[i] = rope_cs(ang); }
        i = gt;
        for (; i + 7 * NT < (size_t)MTOK * 32; i += 8 * NT) { int pv[8];
#pragma unroll
            for (int k = 0; k < 8; ++k) pv[k] = pos[(i + k * NT) >> 5];
#pragma unroll
            for (int k = 0; k < 8; ++k) { const int fi = (int)((i + k * NT) & 31); const float inv = __builtin_amdgcn_exp2f(-(float)(2 * fi) * (13.287712379549449f / 64.0f)); const float ang = (float)pv[k] * inv; RN[i + k * NT] = rope_cs(ang); } }
        for (; i < (size_t)MTOK * 32; i += NT) { const int tok = (int)(i >> 5), fi = (int)(i & 31);
            const float inv = __builtin_amdgcn_exp2f(-(float)(2 * fi) * (13.287712379549449f / 64.0f)); const float ang = (float)pos[tok] * inv; RN[i] = rope_cs(ang); }
    }
    for (int it = gw; it < 128; it += NGW) {
        const int which = it >> 6, jb = (it >> 4) & 3, kr = it & 15;
        const float* pe = P.in[which ? 10 : 7]; const float* w1 = P.in[which ? 11 : 8];
        float a = 0.f;
        for (int k0 = kr * 128; k0 < kr * 128 + 128; k0 += 16) { float pv[16], wv[16];
#pragma unroll
            for (int k = 0; k < 16; ++k) { pv[k] = pe[k0 + k]; wv[k] = w1[(size_t)(k0 + k) * 256 + jb * 64 + lane]; }
#pragma unroll
            for (int k = 0; k < 16; ++k) a += pv[k] * wv[k]; }
        ((float*)(ws + WS_CBIAS))[(which * 16 + kr) * 256 + jb * 64 + lane] = a;
    }
}

constexpr int RQ_OFF = 0, RK_OFF = 17408, RKT_OFF = 34816, RVT_OFF = 53248, RSN_OFF = 90112, RRED_OFF = 99328;
DI void ret_unit(const Params& P, unsigned char* ws, LAS unsigned char* lds, int bl, int h, int tid, int lane, int w, bool dry) {
    bf16_t* PROJ = (bf16_t*)(ws + WS_PROJ);
    const float* gn = P.in[5];
    const int l31 = lane & 31, hh = lane >> 5;
    const float lg = log2f(1.0f - exp2f(-5.0f - (float)h));
    const float g64 = exp2f(64.0f * lg);
    LAS unsigned char* Qs = lds + RQ_OFF; LAS unsigned char* Ks = lds + RK_OFF; LAS unsigned char* Kts = lds + RKT_OFF; LAS unsigned char* Vts = lds + RVT_OFF; LAS unsigned char* Sn = lds + RSN_OFF;
    LAS float* red = (LAS float*)(lds + RRED_OFF);
    f32x16 R[4];
#pragma unroll
    for (int d = 0; d < 4; ++d)
#pragma unroll
        for (int i = 0; i < 16; ++i) R[d][i] = 0.f;
    const size_t rowbase = (size_t)bl * SEQ;
    const int lrow = tid & 63;
    u32x4 pq[2], pk[2], pv[4];
    {
        const bf16_t* src = PROJ + (rowbase + lrow) * PLD + h * 128;
#pragma unroll
        for (int it = 0; it < 2; ++it) { pq[it] = *(GAS const u32x4*)(PROJ + (rowbase + 4 * w + (lane >> 4) + 32 * it) * PLD + h * 128 + C_RQ + (lane & 15) * 8);     pk[it] = *(GAS const u32x4*)(src + C_RK + (w + 8 * it) * 8); }
        const bf16_t* srcv = PROJ + (rowbase + lrow) * PLD + C_RV + h * 256;
#pragma unroll
        for (int it = 0; it < 4; ++it) pv[it] = *(GAS const u32x4*)(srcv + (w + 8 * it) * 8);
    }
    const float zrow = __builtin_amdgcn_exp2f((float)(63 - lrow) * lg);
#pragma unroll 1
    for (int c = 0; c < 32; ++c) {
        const int t0 = c * 64;
#pragma unroll
        for (int it = 0; it < 2; ++it) {
            const int ch = w + 8 * it;
            *(LAS u32x4*)(Qs + (4 * w + (lane >> 4) + 32 * it) * 272 + (lane & 15) * 16) = pq[it]; *(LAS u32x4*)(Ks + lrow * 272 + ch * 16) = pk[it];
#pragma unroll
            for (int i = 0; i < 4; ++i) {
                const unsigned kz = pk2(bflo(pk[it][i]) * zrow, bfhi(pk[it][i]) * zrow);
                *(LAS bf16_t*)(Kts + (ch * 8 + 2 * i) * 144 + lrow * 2) = (bf16_t)(kz & 0xffffu);
                *(LAS bf16_t*)(Kts + (ch * 8 + 2 * i + 1) * 144 + lrow * 2) = (bf16_t)(kz >> 16);
            }
        }
#pragma unroll
        for (int it = 0; it < 4; ++it) {
            const int ch = w + 8 * it;
#pragma unroll
            for (int i = 0; i < 4; ++i) {
                *(LAS bf16_t*)(Vts + (ch * 8 + 2 * i) * 144 + lrow * 2) = (bf16_t)(pv[it][i] & 0xffffu);
                *(LAS bf16_t*)(Vts + (ch * 8 + 2 * i + 1) * 144 + lrow * 2) = (bf16_t)(pv[it][i] >> 16);
            }
        }
        __syncthreads();
        if (c + 1 < 32) {
            const bf16_t* src = PROJ + (rowbase + t0 + 64 + lrow) * PLD + h * 128;
#pragma unroll
            for (int it = 0; it < 2; ++it) { pq[it] = *(GAS const u32x4*)(PROJ + (rowbase + t0 + 64 + 4 * w + (lane >> 4) + 32 * it) * PLD + h * 128 + C_RQ + (lane & 15) * 8); pk[it] = *(GAS const u32x4*)(src + C_RK + (w + 8 * it) * 8); }
            const bf16_t* srcv = PROJ + (rowbase + t0 + 64 + lrow) * PLD + C_RV + h * 256;
#pragma unroll
            for (int it = 0; it < 4; ++it) pv[it] = *(GAS const u32x4*)(srcv + (w + 8 * it) * 8);
        }
        f32x16 O[2];
#pragma unroll
        for (int nt = 0; nt < 2; ++nt)
#pragma unroll
            for (int i = 0; i < 16; ++i) O[nt][i] = 0.f;
#pragma unroll
        for (int dt = 0; dt < 4; ++dt) {
            const bf16x8 a0 = pack8<0>(R[dt]), a1 = pack8<1>(R[dt]);
#pragma unroll
            for (int nt = 0; nt < 2; ++nt) {
                const bf16x8 b0 = lds8x2(Qs + (32 * nt + l31) * 272 + (32 * dt + 4 * hh) * 2);
                const bf16x8 b1 = lds8x2(Qs + (32 * nt + l31) * 272 + (32 * dt + 16 + 4 * hh) * 2);
                O[nt] = MFMA32(a0, b0, O[nt]); O[nt] = MFMA32(a1, b1, O[nt]);
            }
        }
#pragma unroll
        for (int nt = 0; nt < 2; ++nt) { const float xi = __builtin_amdgcn_exp2f((float)(32 * nt + l31 + 1) * lg);
#pragma unroll
            for (int i = 0; i < 16; ++i) O[nt][i] *= xi; }
        if (w < 4) {
            const int mt = w >> 1, nt = w & 1;
            f32x16 s;
#pragma unroll
            for (int i = 0; i < 16; ++i) s[i] = 0.f;
#pragma unroll
            for (int st = 0; st < 8; ++st) {
                const bf16x8 a = lds16(Ks + (32 * mt + l31) * 272 + (16 * st + 8 * hh) * 2);
                const bf16x8 b = lds16(Qs + (32 * nt + l31) * 272 + (16 * st + 8 * hh) * 2);
                s = MFMA32(a, b, s);
            }
            const int n = 32 * nt + l31;
            int dbase = n - 32 * mt - 4 * hh; asm volatile("" : "+v"(dbase));
#pragma unroll
            for (int i = 0; i < 16; ++i) { const int dl = dbase - ((i & 3) + 8 * (i >> 2)); s[i] = dl >= 0 ? s[i] * __builtin_amdgcn_exp2f((float)dl * lg) : 0.f; }
#pragma unroll
            for (int g = 0; g < 4; ++g) { u32x2 wv; wv[0] = pk2(s[4 * g], s[4 * g + 1]); wv[1] = pk2(s[4 * g + 2], s[4 * g + 3]);
                *(LAS u32x2*)(Sn + n * 144 + (32 * mt + 8 * g + 4 * hh) * 2) = wv; }
        }
        __syncthreads();
#pragma unroll
        for (int d = 0; d < 4; ++d)
#pragma unroll
            for (int i = 0; i < 16; ++i) R[d][i] *= g64;
#pragma unroll
        for (int st = 0; st < 4; ++st) {
            const bf16x8 v = lds16(Vts + (32 * w + l31) * 144 + (16 * st + 8 * hh) * 2);
#pragma unroll
            for (int nt = 0; nt < 2; ++nt) { const bf16x8 b = lds16(Sn + (32 * nt + l31) * 144 + (16 * st + 8 * hh) * 2); O[nt] = MFMA32(v, b, O[nt]); }
#pragma unroll
            for (int dt = 0; dt < 4; ++dt) { const bf16x8 a = lds16(Kts + (32 * dt + l31) * 144 + (16 * st + 8 * hh) * 2); R[dt] = MFMA32(a, v, R[dt]); }
        }
#pragma unroll
        for (int nt = 0; nt < 2; ++nt) {
            float s1 = 0.f, s2 = 0.f;
#pragma unroll
            for (int i = 0; i < 16; ++i) { s1 += O[nt][i]; s2 += O[nt][i] * O[nt][i]; }
            s1 += shx(s1, 32, lane); s2 += shx(s2, 32, lane);
            if (hh == 0) { red[(w * 64 + 32 * nt + l31) * 2] = s1; red[(w * 64 + 32 * nt + l31) * 2 + 1] = s2; }
        }
        __syncthreads();
#pragma unroll
        for (int nt = 0; nt < 2; ++nt) {
            const int n = 32 * nt + l31;
            float S1 = 0.f, S2 = 0.f;
#pragma unroll
            for (int ww = 0; ww < 8; ++ww) { S1 += red[(ww * 64 + n) * 2]; S2 += red[(ww * 64 + n) * 2 + 1]; }
            const float mean = S1 * (1.f / 256.f); const float var = fmaxf(S2 * (1.f / 256.f) - mean * mean, 0.f); const float rstd = rsqrtf(var + EPS);
            bf16_t* rowp = PROJ + (rowbase + t0 + n) * PLD + h * 256;
#pragma unroll
            for (int g = 0; g < 4; ++g) {
                const int e0 = 32 * w + 8 * g + 4 * hh;
                const u32x2 gt = *(GAS const u32x2*)(rowp + C_RG + e0);
                const f32x4 gg = *(GAS const f32x4*)(gn + h * 256 + e0);
                const float gv[4] = {bflo(gt[0]), bfhi(gt[0]), bflo(gt[1]), bfhi(gt[1])};
                float y[4];
#pragma unroll
                for (int k = 0; k < 4; ++k) { const float sl = gv[k] * __builtin_amdgcn_rcpf(1.0f + __expf(-gv[k])); y[k] = (O[nt][4 * g + k] - mean) * rstd * gg[k] * sl; }
                u32x2 wv; wv[0] = pk2(y[0], y[1]); wv[1] = pk2(y[2], y[3]);
                if (!dry) *(GAS u32x2*)(rowp + C_RV + e0) = wv;
            }
        }
    }
}

constexpr int NBUF = 18432, NIG_OFF = 36864, NIL_OFF = 45312, NSEL_OFF = 53760, NUNI_OFF = 54016, NQ_OFF = 54272, NEMIT_OFF = 128000;
DI void gload_kv(const bf16_t* Kg, const bf16_t* Vg, u32x4& rk, u32x4& rv, int w) {
    const int key = lane_id_asm(), ch = w;
    const int tk = w * 64 + key;
    rk = *(GAS const u32x4*)(Kg + tk * 8); rv = *(GAS const u32x4*)(Vg + key * 64 + ch * 8);
}
DI void st_kv(LAS unsigned char* buf, const u32x4& rk, const u32x4& rv, int w) {
    const int key = lane_id_asm(), ch = w;
    LAS unsigned char* Ks = buf; LAS unsigned char* Vts = buf + 9216;
    { const int tk = w * 64 + key; *(LAS u32x4*)(Ks + (tk >> 3) * 144 + (tk & 7) * 16) = rk; }
    const int kpos = (key & ~15) + (key & 3) + 4 * ((key >> 3) & 1) + 8 * ((key >> 2) & 1);
#pragma unroll
    for (int i = 0; i < 4; ++i) {
        *(LAS bf16_t*)(Vts + (ch * 8 + 2 * i) * 144 + kpos * 2) = (bf16_t)(rv[i] & 0xffffu);
        *(LAS bf16_t*)(Vts + (ch * 8 + 2 * i + 1) * 144 + kpos * 2) = (bf16_t)(rv[i] >> 16);
    }
}
DI constexpr bool q_dead(int mode, int kt, int qt) { return (mode == 1 && kt == 1 && qt == 0) || (mode == 2 && kt == 0 && qt == 1); }
DI constexpr bool q_full(int mode, int kt, int qt) { return mode == 0 || (mode == 1 && kt == 0 && qt == 1) || (mode == 2 && kt == 1 && qt == 0); }
template <int MODE, int PASS, bool SEL>
DI void attn_step(LAS unsigned char* lds, LAS unsigned char* buf, LAS unsigned char* Qw, f32x16 (&O)[2][2], float (&m)[2], float (&l)[2], const bool (&selok)[2],
                  int l31, int hh, int cb, int q0, int tile, int lane) {
    LAS unsigned char* Ks = buf; LAS unsigned char* Vts = buf + 9216;
    lane = lane_id_asm(); l31 = lane & 31; hh = lane >> 5;
    f32x16 st[2][2];
#pragma unroll
    for (int kt = 0; kt < 2; ++kt)
#pragma unroll
        for (int qt = 0; qt < 2; ++qt)
#pragma unroll
            for (int i = 0; i < 16; ++i) st[kt][qt][i] = 0.f;
#pragma unroll
    for (int s = 0; s < 4; ++s) {
        const bf16x8 qb0 = lds16(Qw + l31 * 144 + (16 * s + 8 * hh) * 2), qb1 = lds16(Qw + (32 + l31) * 144 + (16 * s + 8 * hh) * 2);
#pragma unroll
        for (int kt = 0; kt < 2; ++kt) {
            const bf16x8 a = lds16(Ks + (32 * kt + l31) * 144 + (16 * s + 8 * hh) * 2);
            if (!q_dead(MODE, kt, 0)) st[kt][0] = MFMA32(a, qb0, st[kt][0]);
            if (!q_dead(MODE, kt, 1)) st[kt][1] = MFMA32(a, qb1, st[kt][1]);
        }
        if (s == 1) asm volatile("" ::: "memory");
    }
    float subv[2] = {0.f, 0.f};
#pragma unroll
    for (int qt = 0; qt < 2; ++qt) {
        const int qrel = 32 * qt + l31;
        if (MODE != 0) {
#pragma unroll
            for (int kt = 0; kt < 2; ++kt)
#pragma unroll
                for (int i = 0; i < 16; ++i) {
                    if (q_dead(MODE, kt, qt) || q_full(MODE, kt, qt)) continue;
                    const int krel = 32 * kt + crow(i, hh);
                    bool ok = true;
                    if (MODE == 1) ok = (krel <= qrel);
                    if (MODE == 2) ok = (krel > qrel);
                    if (MODE == 3) ok = (16 * (cb + krel) + 31 <= q0 + qrel);
                    st[kt][qt][i] = ok ? st[kt][qt][i] : -1e30f;
                }
        }
        if (PASS != 2) {
            float mx = -1e30f;
#pragma unroll
            for (int kt = 0; kt < 2; ++kt)
#pragma unroll
                for (int i = 0; i < 16; ++i) if (!q_dead(MODE, kt, qt)) mx = fmaxf(mx, st[kt][qt][i]);
            mx = fmaxf(mx, shx(mx, 32, lane));
            if (SEL) mx = selok[qt] ? mx : -1e30f;
            const float mold = m[qt];
            const float mnew = fmaxf(mold, mx);
            const float alpha = __builtin_amdgcn_exp2f(mold - mnew);
            m[qt] = mnew;
            subv[qt] = (SEL && !selok[qt]) ? 1e30f : ((mnew > -1e29f) ? mnew : 0.f);
            l[qt] *= alpha;
            if (PASS == 0) {
#pragma unroll
                for (int dt = 0; dt < 2; ++dt)
#pragma unroll
                    for (int i = 0; i < 16; ++i) O[dt][qt][i] *= alpha;
            }
        } else subv[qt] = (m[qt] > -1e29f) ? m[qt] : 0.f;
    }
#pragma unroll
    for (int kt = 0; kt < 2; ++kt) {
#pragma unroll
        for (int qt = 0; qt < 2; ++qt) {
            if (q_dead(MODE, kt, qt)) continue;
            if (PASS != 2) {
                float sum = 0.f;
#pragma unroll
                for (int i = 0; i < 16; ++i) { const float p = __builtin_amdgcn_exp2f(st[kt][qt][i] - subv[qt]); st[kt][qt][i] = p; sum += p; }
                l[qt] += sum;
            } else {
                LAS int* IG = (LAS int*)(lds + NIG_OFF); LAS int* IL = (LAS int*)(lds + NIL_OFF);
                const int qrel = 32 * qt + l31;
#pragma unroll
                for (int i = 0; i < 16; ++i) st[kt][qt][i] = __builtin_amdgcn_exp2f(st[kt][qt][i] - subv[qt]) * l[qt];
#pragma unroll
                for (int g = 0; g < 4; ++g) {
                    const float gs = (st[kt][qt][4 * g] + st[kt][qt][4 * g + 1]) + (st[kt][qt][4 * g + 2] + st[kt][qt][4 * g + 3]);
                    const int cg = 16 * tile + 8 * kt + 2 * g + hh;
                    (void)__hip_atomic_fetch_add(IG + qrel * 33 + cg, (int)(gs * 16777216.0f + 0.5f), __ATOMIC_RELAXED, __HIP_MEMORY_SCOPE_WORKGROUP);
                    (void)__hip_atomic_fetch_add(IL + qrel * 33 + cg, (int)(st[kt][qt][4 * g + 3] * 16777216.0f + 0.5f), __ATOMIC_RELAXED, __HIP_MEMORY_SCOPE_WORKGROUP);
                }
            }
        }
        if (PASS != 1) {
            const bf16x8 p00 = pack8<0>(st[kt][0]), p01 = pack8<0>(st[kt][1]), p10 = pack8<1>(st[kt][0]), p11 = pack8<1>(st[kt][1]);
#pragma unroll
            for (int dt = 0; dt < 2; ++dt) {
                const bf16x8 v0 = lds16(Vts + (32 * dt + l31) * 144 + (32 * kt + 8 * hh) * 2);
                const bf16x8 v1 = lds16(Vts + (32 * dt + l31) * 144 + (32 * kt + 16 + 8 * hh) * 2);
                if (!q_dead(MODE, kt, 0)) { O[dt][0] = MFMA32(v0, p00, O[dt][0]); O[dt][0] = MFMA32(v1, p10, O[dt][0]); }
                if (!q_dead(MODE, kt, 1)) { O[dt][1] = MFMA32(v0, p01, O[dt][1]); O[dt][1] = MFMA32(v1, p11, O[dt][1]); }
            }
        }
    }
}
template <bool ADD> DI void nsa_emit(bf16_t* obase  , const f32x16 (&O)[2][2], const float (&sc)[2], LAS unsigned char* scr  , bool dry) {
    const int ln_ = lane_id_asm(); const int l31 = ln_ & 31, hh = ln_ >> 5, qp = ln_ >> 1, hf = ln_ & 1;
#pragma unroll
    for (int qt = 0; qt < 2; ++qt)
#pragma unroll
        for (int dt = 0; dt < 2; ++dt) {
#pragma unroll
            for (int g = 0; g < 4; ++g) {
                u32x2 wv; wv[0] = pk2(O[dt][qt][4 * g] * sc[qt], O[dt][qt][4 * g + 1] * sc[qt]); wv[1] = pk2(O[dt][qt][4 * g + 2] * sc[qt], O[dt][qt][4 * g + 3] * sc[qt]);
                *(LAS u32x2*)(scr + l31 * 72 + (8 * g + 4 * hh) * 2) = wv;
            }
            asm volatile("s_waitcnt lgkmcnt(0)" ::: "memory");
            u32x2 r[4];
#pragma unroll
            for (int i = 0; i < 4; ++i) r[i] = *(LAS u32x2*)(scr + qp * 72 + hf * 32 + 8 * i);
            asm volatile("s_waitcnt lgkmcnt(0)" ::: "memory");
            GAS u32x4* gp = (GAS u32x4*)(obase + (size_t)(32 * qt + qp) * PLD + 32 * dt + 16 * hf);
            u32x4 w0 = {r[0][0], r[0][1], r[1][0], r[1][1]}, w1 = {r[2][0], r[2][1], r[3][0], r[3][1]};
            if (ADD) {
                const u32x4 o0 = gp[0], o1 = gp[1];
#pragma unroll
                for (int i = 0; i < 4; ++i) { w0[i] = pk2(bflo(w0[i]) + bflo(o0[i]), bfhi(w0[i]) + bfhi(o0[i])); w1[i] = pk2(bflo(w1[i]) + bflo(o1[i]), bfhi(w1[i]) + bfhi(o1[i])); }
            }
            if (!dry) { gp[0] = w0; gp[1] = w1; }
        }
}
DI void zeroO(f32x16 (&O)[2][2]) {
#pragma unroll
    for (int a = 0; a < 2; ++a)
#pragma unroll
        for (int b = 0; b < 2; ++b)
#pragma unroll
            for (int i = 0; i < 16; ++i) O[a][b][i] = 0.f;
}
DI int next_sel(unsigned uni, int j, int qi) {
    const unsigned rest = (j >= 31) ? 0u : (uni >> (j + 1));
    if (!rest) return 64;
    const int n = j + 1 + __builtin_ctz(rest);
    return n <= qi ? n : 64;
}
DI void nsa_unit(const Params& P, unsigned char* ws, LAS unsigned char* lds, int bl, int g, int qi, int tid, int lane, int w, bool dry) {
    bf16_t* PROJ = (bf16_t*)(ws + WS_PROJ);
    const int l31 = lane & 31, hh = lane >> 5, head = g * 8 + w, bg = bl * 2 + g, q0 = qi * 64;
    const size_t rowbase = (size_t)bl * SEQ;
    const bf16_t* KCO = (const bf16_t*)(ws + WS_KCO) + (size_t)bg * 128 * 64; const bf16_t* VCO = (const bf16_t*)(ws + WS_VCO) + (size_t)bg * 128 * 64;
    const bf16_t* KS = (const bf16_t*)(ws + WS_KV + 2 * KVBUF) + (size_t)bg * SEQ * 64; const bf16_t* VS = (const bf16_t*)(ws + WS_KV + 3 * KVBUF) + (size_t)bg * SEQ * 64;
    const bf16_t* KW = (const bf16_t*)(ws + WS_KV + 4 * KVBUF) + (size_t)bg * SEQ * 64; const bf16_t* VW = (const bf16_t*)(ws + WS_KV + 5 * KVBUF) + (size_t)bg * SEQ * 64;
    LAS int* IG = (LAS int*)(lds + NIG_OFF); LAS int* IL = (LAS int*)(lds + NIL_OFF);
    LAS unsigned* SELM = (LAS unsigned*)(lds + NSEL_OFF); LAS unsigned* UNI = (LAS unsigned*)(lds + NUNI_OFF);
    bf16_t* obase = PROJ + (rowbase + q0) * PLD + C_NQ + head * 64;
    LAS unsigned char* Qw = lds + NQ_OFF + w * 9216;
    {
        const int qr = lane >> 3, qp = lane & 7;
#pragma unroll
        for (int it = 0; it < 8; ++it)
            *(LAS bf16x8*)(Qw + (8 * it + qr) * 144 + qp * 16) = *(GAS const bf16x8*)(PROJ + (rowbase + q0 + 8 * it + qr) * PLD + C_NQ + head * 64 + qp * 8);
    }
#define NSA_GATE(br, qt) bf2f(((GAS const bf16_t*)PROJ)[(rowbase + q0 + 32 * (qt) + l31e) * PLD + C_NG + (br) * 16 + head])
    for (int i = tid; i < 2 * 64 * 33; i += 512) IG[i] = 0;
    if (tid == 0) UNI[0] = 0u;
    f32x16 O[2][2]; float m[2], l[2]; bool selok[2] = {true, true};
    u32x4 rk, rv;
    const int ntile = (1024 + 31 <= q0 + 63) ? 2 : 1;
    m[0] = m[1] = -1e30f; l[0] = l[1] = 0.f;
    for (int tile = 0; tile < ntile; ++tile) { gload_kv(KCO + tile * 4096, VCO + tile * 4096, rk, rv, w); st_kv(lds + tile * NBUF, rk, rv, w); }
    __syncthreads();
    for (int tile = 0; tile < ntile; ++tile) attn_step<3, 1, false>(lds, lds + tile * NBUF, Qw, O, m, l, selok, l31, hh, 64 * tile, q0, tile, lane);
#pragma unroll
    for (int qt = 0; qt < 2; ++qt) { const float lt = l[qt] + shx(l[qt], 32, lane); l[qt] = lt > 0.f ? 1.0f / lt : 0.f; }
    zeroO(O);
    for (int tile = 0; tile < ntile; ++tile) attn_step<3, 2, false>(lds, lds + tile * NBUF, Qw, O, m, l, selok, l31, hh, 64 * tile, q0, tile, lane);
    { const int l31e = lane_id_asm() & 31; const float sc[2] = {NSA_GATE(0, 0), NSA_GATE(0, 1)}; nsa_emit<false>(obase, O, sc, lds + NEMIT_OFF + w * 2304, dry); }
    __syncthreads();
    gload_kv(KS, VS, rk, rv, w);
    {
        const int tsel = w * 64 + lane_id_asm(); const int q = tsel >> 3, pp = tsel & 7;
        LAS int* Gq = IG + q * 33; LAS int* Lq = IL + q * 33;
        int sc4[4];
#pragma unroll
        for (int k = 0; k < 4; ++k) { const int n = 4 * pp + k;
            const int imp = Gq[n] + (n > 0 ? Lq[n - 1] : 0);
            const bool forced = (n == 0) || (n == qi) || (n == qi - 1);
            sc4[k] = forced ? 0x7fffffff : (n <= qi ? imp : -1); }
        __syncthreads();
#pragma unroll
        for (int k = 0; k < 4; ++k) Gq[4 * pp + k] = sc4[k];
        __syncthreads();
        int rank[4] = {0, 0, 0, 0};
        for (int n2 = 0; n2 < 32; ++n2) { const int v = Gq[n2];
#pragma unroll
            for (int k = 0; k < 4; ++k) rank[k] += (v > sc4[k] || (v == sc4[k] && n2 < 4 * pp + k)) ? 1 : 0; }
        unsigned bits = 0u;
#pragma unroll
        for (int k = 0; k < 4; ++k) bits |= (rank[k] < 8) ? (1u << (4 * pp + k)) : 0u;
        const int ln = tsel & 63;
        bits |= shxu(bits, 1, ln); bits |= shxu(bits, 2, ln); bits |= shxu(bits, 4, ln);
        if (pp == 0) SELM[q] = bits;
        unsigned u = bits;
        u |= shxu(u, 8, ln); u |= shxu(u, 16, ln); u |= shxu(u, 32, ln);
        if (ln == 0) (void)__hip_atomic_fetch_or(UNI, u, __ATOMIC_RELAXED, __HIP_MEMORY_SCOPE_WORKGROUP);
    }
    st_kv(lds, rk, rv, w);
    __syncthreads();
    const unsigned uni = (unsigned)__builtin_amdgcn_readfirstlane((int)UNI[0]);
    zeroO(O); m[0] = m[1] = -1e30f; l[0] = l[1] = 0.f;
    int b = 0;
    {
        int j = 0;
        while (j < 64) {
            const int nj = next_sel(uni, j, qi);
            if (nj < 64) gload_kv(KS + (size_t)nj * 4096, VS + (size_t)nj * 4096, rk, rv, w);
            else gload_kv(KW + (size_t)(qi >= 8 ? qi - 8 : 0) * 4096, VW + (size_t)(qi >= 8 ? qi - 8 : 0) * 4096, rk, rv, w);
            selok[0] = (SELM[l31] >> j) & 1u; selok[1] = (SELM[32 + l31] >> j) & 1u;
            if (j == qi) attn_step<1, 0, true>(lds, lds + b * NBUF, Qw, O, m, l, selok, l31, hh, 0, q0, 0, lane);
            else attn_step<0, 0, true>(lds, lds + b * NBUF, Qw, O, m, l, selok, l31, hh, 0, q0, 0, lane);
            st_kv(lds + (b ^ 1) * NBUF, rk, rv, w);
            __syncthreads();
            b ^= 1; j = nj;
        }
    }
    { float sc[2]; const int l31e = lane_id_asm() & 31;
#pragma unroll
      for (int qt = 0; qt < 2; ++qt) { const float lt = l[qt] + shx(l[qt], 32, lane); sc[qt] = lt > 0.f ? NSA_GATE(1, qt) / lt : 0.f; }
      nsa_emit<true>(obase, O, sc, lds + NEMIT_OFF + w * 2304, dry); }
    zeroO(O); m[0] = m[1] = -1e30f; l[0] = l[1] = 0.f; selok[0] = selok[1] = true;
    for (int j = (qi >= 8 ? qi - 8 : 0); j <= qi; ++j) {
        if (j < qi) gload_kv(KW + (size_t)(j + 1) * 4096, VW + (size_t)(j + 1) * 4096, rk, rv, w);
        if (j == qi) attn_step<1, 0, false>(lds, lds + b * NBUF, Qw, O, m, l, selok, l31, hh, 0, q0, 0, lane);
        else if (j == qi - 8) attn_step<2, 0, false>(lds, lds + b * NBUF, Qw, O, m, l, selok, l31, hh, 0, q0, 0, lane);
        else attn_step<0, 0, false>(lds, lds + b * NBUF, Qw, O, m, l, selok, l31, hh, 0, q0, 0, lane);
        if (j < qi) st_kv(lds + (b ^ 1) * NBUF, rk, rv, w);
        __syncthreads();
        b ^= 1;
    }
    { float sc[2]; const int l31e = lane_id_asm() & 31;
#pragma unroll
      for (int qt = 0; qt < 2; ++qt) { const float lt = l[qt] + shx(l[qt], 32, lane); sc[qt] = lt > 0.f ? NSA_GATE(2, qt) / lt : 0.f; }
      nsa_emit<true>(obase, O, sc, lds + NEMIT_OFF + w * 2304, dry); }
}


enum { S_PRO = 0, S_GEMM, S_MIX, S_NORM, S_FINAL };
constexpr int NSTEPS = 22;

__global__ void __launch_bounds__(512, 2) fwd_megakernel(Params P) {
    extern __shared__ __attribute__((aligned(16))) unsigned char lds_raw[];
    LAS unsigned char* lds = (LAS unsigned char*)lds_raw;
    cg::grid_group grid = cg::this_grid();
    const int G = gridDim.x;
    const int wave0 = __builtin_amdgcn_readfirstlane((int)threadIdx.x >> 6);
    if (threadIdx.x < 8) ((LAS unsigned*)(lds + LDS_BYTES - 32))[threadIdx.x] = 0u;
    __syncthreads();
    const XcdBarrier xbar = xcd_barrier_post((unsigned*)(P.ws + WS_CTL) + 4096, (volatile LAS unsigned*)(lds + LDS_BYTES - 32));

    if (G > (1 << 30)) grid.sync();
#pragma unroll 1
#ifdef PROBE_DBL_STEP
    for (int step_ = 0; step_ < NSTEPS + 1; ++step_) {
        const int step = (step_ == NSTEPS) ? PROBE_DBL_STEP : step_;
#else
    for (int step = 0; step < NSTEPS; ++step) {
#endif
#define FRESH_TID() int tid = wave0 * 64 + lane_id_asm(); asm volatile("" : "+v"(tid)); const int lane = tid & 63, wave = __builtin_amdgcn_readfirstlane(tid >> 6); (void)lane; (void)wave
        unsigned char* ws = P.ws; asm volatile("" : "+s"(ws));
        bf16_t* PROJ = (bf16_t*)(ws + WS_PROJ);
        bf16_t* Hb = (bf16_t*)(ws + WS_H);
        bf16_t* Ub = (bf16_t*)(ws + WS_PROJ);
        bf16_t* Gb = (bf16_t*)(ws + WS_PROJ);
        int kind = S_GEMM, half = 0, sub = 0, sync_after = 1;
        if (step == 0) kind = S_PRO;
        else if (step <= 14) { half = (step - 1) / 7; sub = (step - 1) % 7; if (sub == 3) kind = S_MIX; if (sub == 4 || sub == 1) sync_after = 0; }
        else { sub = step - 15 + 7; if (step == 15 || step == 18) { kind = S_NORM; sync_after = 0; } if (step == 21) { kind = S_FINAL; sync_after = 0; } }

        half = __builtin_amdgcn_readfirstlane(half); sub = __builtin_amdgcn_readfirstlane(sub); kind = __builtin_amdgcn_readfirstlane(kind);
        if (kind == S_PRO) {
            FRESH_TID();
            prologue(P, ws, lds, tid, lane, wave);
        } else if (kind == S_GEMM) {
            FRESH_TID();
            pg8::Gemm g; EpiAll E; int Gs = G, c = blockIdx.x;
            E.kind = K_CAT; E.half = half; E.flag = 0; E.ldf = DM; E.ldh = 0; E.ldg = 0; E.fb = nullptr; E.fo = nullptr; E.hg = nullptr; E.ho = nullptr; E.ws = ws; E.gvec = nullptr; E.ssout = nullptr;
            g.A = nullptr; g.Bt = nullptr; g.M = 0; g.N = 0; g.K = 0; g.lda = 0;
            switch (sub) {
            case 0:
                g.A = Hb + (size_t)half * MH * DM; g.Bt = (const bf16_t*)(ws + WS_WCAT); g.M = MH; g.N = NCAT; g.K = DM; g.lda = DM; E.kind = K_CAT; break;
            case 1: {
                const int which = (c >= G / 2) ? 1 : 0; Gs = G / 2; c = c - which * (G / 2);
                g.A = (const bf16_t*)(ws + WS_KV + (size_t)which * KVBUF); g.Bt = (const bf16_t*)(ws + (which ? WS_WC1V : WS_WC1K)); g.M = 4096; g.N = 256; g.K = 2048; g.lda = 1024;
                E.kind = K_CMP1; E.fb = (const float*)(ws + WS_CBIAS) + which * 16 * 256; E.ho = (bf16_t*)(ws + WS_CH + (size_t)which * 2 * MiB); E.ldh = 256; break; }
            case 2: {
                const int which = (c >= G / 2) ? 1 : 0; Gs = G / 2; c = c - which * (G / 2);
                g.A = (const bf16_t*)(ws + WS_CH + (size_t)which * 2 * MiB); g.Bt = (const bf16_t*)(ws + (which ? WS_WC2V : WS_WC2K)); g.M = 4096; g.N = 256; g.K = 256; g.lda = 256;
                E.kind = K_CMP2; E.ho = (bf16_t*)(ws + (which ? WS_VCO : WS_KCO)); E.ldh = 64; break; }
            case 4:
                g.A = PROJ + C_RV; g.Bt = (const bf16_t*)(ws + WS_WRO); g.M = MH; g.N = DM; g.K = 2048; g.lda = PLD;
                E.kind = K_GATE; E.flag = 0; E.hg = PROJ + C_MG; E.ldg = PLD; E.ho = PROJ; E.ldh = PLD; break;
            case 5:
                g.A = PROJ + C_NQ; g.Bt = (const bf16_t*)(ws + WS_WNO); g.M = MH; g.N = DM; g.K = DM; g.lda = PLD;
                E.kind = K_GATE; E.flag = 1; E.hg = PROJ + C_MG + DM; E.ldg = PLD; E.ho = PROJ; E.ldh = PLD; break;
            case 6:
                g.A = PROJ; g.Bt = (const bf16_t*)(ws + WS_WOUT); g.M = MH; g.N = DM; g.K = DM; g.lda = PLD;
                E.kind = K_RES; E.fb = P.in[0] + (size_t)half * MH * DM; E.ldf = DM;
                E.ho = Hb + (size_t)half * MH * DM; E.ldh = DM; E.ssout = (float*)(ws + WS_SS1) + (size_t)half * MH; break;
            case 8:
                g.A = Hb; g.Bt = (const bf16_t*)(ws + WS_WUP); g.M = MTOK; g.N = FF; g.K = DM; g.lda = DM; E.kind = K_RELU2; E.ho = Ub; E.ldh = FF; E.fb = (const float*)(ws + WS_SS1); break;
            case 9:
                g.A = Ub; g.Bt = (const bf16_t*)(ws + WS_WDN); g.M = MTOK; g.N = DM; g.K = FF; g.lda = FF; E.kind = K_RES; E.fb = nullptr;
                E.ho = Hb; E.ldh = DM; E.ssout = (float*)(ws + WS_SS2); break;
            case 11:
                g.A = Hb; g.Bt = (const bf16_t*)(ws + WS_WPG); g.M = MTOK; g.N = DM; g.K = DM; g.lda = DM; E.kind = K_SIG; E.ho = Gb; E.ldh = DM; E.fb = (const float*)(ws + WS_SS2); break;
            default:
                g.A = (const bf16_t*)(ws + WS_PB); g.Bt = (const bf16_t*)(ws + WS_WPP); g.M = MTOK; g.N = DM; g.K = PLE; g.lda = PLE;
                E.kind = K_MULRES; E.ho = Hb; E.ldh = DM; E.hg = Gb; E.ldg = DM; break;
            }
#if defined(PROBE_DBL_STEP) && defined(PROBE_HALF_M)
            if (step_ == NSTEPS) g.M >>= 1;
#endif
            pg8::StaticOrder S; S.init(g.M, g.N, Gs, c);
            pg8::gemm_phase<EpiAll, pg8::StaticOrder, true, true>(lds, g, S, E, tid);
            if (sub == 1) {
                __builtin_amdgcn_fence(__ATOMIC_RELEASE, "agent"); __syncthreads(); __builtin_amdgcn_fence(__ATOMIC_ACQUIRE, "agent");
            }
            __syncthreads();
        } else if (kind == S_MIX) {
#ifndef PROBE_MIX_PASSES
#define PROBE_MIX_PASSES 1
#endif
            LAS unsigned* ubox = (LAS unsigned*)(lds + LDS_BYTES - 64);
#pragma unroll 1
            for (int pass = 0; pass < PROBE_MIX_PASSES; ++pass) {
            const bool dry = pass < PROBE_MIX_PASSES - 1;
            unsigned* ctrs = (unsigned*)(ws + WS_CTL) + 512 * (1 + half + 2 * pass);
            if (wave0 * 64 + lane_id_asm() == 0) { ubox[1] = xb_xcc_id() & 7u; ubox[2] = 0u; }
            for (;;) {
                if (wave0 * 64 + lane_id_asm() == 0) {
                    unsigned q = ubox[1], tries = ubox[2], u;
                    for (;;) { u = atomicAdd(ctrs + 64 * q, 1u); if (u < 144u || tries >= 7u) break; q = (q + 1u) & 7u; ++tries; }
                    ubox[1] = q; ubox[2] = tries; ubox[0] = (u < 144u) ? (q * 256u + u) : 0xffffffffu;
                }
                __syncthreads();
                const unsigned uq = ubox[0];
                __syncthreads();
                if (uq == 0xffffffffu) break;
                const unsigned q = uq >> 8, u = uq & 255u;
                int tid2 = wave0 * 64 + lane_id_asm();
                const int lane2 = tid2 & 63, wave2 = __builtin_amdgcn_readfirstlane(tid2 >> 6);
                if (u < 16u) { const unsigned r = q * 16u + u; ret_unit(P, ws, lds, (int)(r >> 3), (int)(r & 7), tid2, lane2, wave2, dry); }
                else { const unsigned v = u - 16u; const unsigned bg = (v & 3u) * 8u + q; nsa_unit(P, ws, lds, (int)(bg >> 1), (int)(bg & 1u), 31 - (int)(v >> 2), tid2, lane2, wave2, dry); }
            }
            if (PROBE_MIX_PASSES > 1) xcd_barrier(xbar);
            }
        } else if (kind == S_NORM) {
        } else {
            FRESH_TID();
            const int gw = blockIdx.x * 8 + wave, NGW = G * 8;
            for (int m = gw; m < MTOK; m += 2 * NGW) if (m + NGW >= MTOK) rms_row_final(Hb + (size_t)m * DM, P.in[22], P.out + (size_t)m * DM, lane); else rms_row2_final(Hb + (size_t)m * DM, Hb + (size_t)(m + NGW) * DM, P.in[22], P.out + (size_t)m * DM, P.out + (size_t)(m + NGW) * DM, lane);
        }
        if (sync_after) { XcdBarrier xb = xbar; asm volatile("" : "+s"(xb.bar)); xcd_barrier(xb); }
#ifdef PROBE_DBL_STEP
        if (step_ == NSTEPS - 1) { XcdBarrier xb = xbar; asm volatile("" : "+s"(xb.bar)); xcd_barrier(xb); }
#endif
#ifdef PROBE_EXTRA_SYNCS
        for (int e = 0; e < PROBE_EXTRA_SYNCS; ++e) xcd_barrier(xbar);
#endif
    }
}

extern "C" void kernel_launch(void* const* d_in, const int* in_sizes, int n_in, void* d_out, int out_size, void* d_ws, size_t ws_size, hipStream_t stream) {
    static int grid = 0;
    if (grid == 0) {
        if (n_in != 23 || ws_size < WS_END) { fprintf(stderr, "kernel_launch: unexpected inputs (n_in %d, ws %zu)\n", n_in, ws_size); grid = -1; return; }
        int dev = 0, cus = 0, per_cu = 0;
        hipGetDevice(&dev); hipDeviceGetAttribute(&cus, hipDeviceAttributeMultiprocessorCount, dev);
        if (hipFuncSetAttribute((const void*)fwd_megakernel, hipFuncAttributeMaxDynamicSharedMemorySize, LDS_BYTES) != hipSuccess) { fprintf(stderr, "kernel_launch: hipFuncSetAttribute failed\n"); grid = -1; return; }
        if (hipOccupancyMaxActiveBlocksPerMultiprocessor(&per_cu, (const void*)fwd_megakernel, 512, LDS_BYTES) != hipSuccess || per_cu < 1) { fprintf(stderr, "kernel_launch: occupancy query gives %d\n", per_cu); per_cu = 1; }
        (void)hipGetLastError();
        grid = cus;
        if (grid > 256) grid = 256;
        if (grid & 1) grid -= 1;
    }
    if (grid < 0) return;
    hipMemsetAsync((char*)d_ws + WS_CTL, 0, CTL_BYTES, stream);
    Params p{};
    for (int i = 0; i < 23; ++i) p.in[i] = (const float*)d_in[i];
    p.out = (float*)d_out; p.ws = (unsigned char*)d_ws;
    void* args[] = {&p};
    hipError_t e = hipLaunchCooperativeKernel((const void*)fwd_megakernel, dim3(grid), dim3(512), args, LDS_BYTES, stream);
    if (e != hipSuccess) fprintf(stderr, "cooperative launch failed: %s (grid %d)\n", hipGetErrorString(e), grid);
}
```

```cpp
#include <hip/hip_runtime.h>
#include <hip/hip_cooperative_groups.h>
#include <cstdio>
#include <cstdint>
namespace cg = cooperative_groups;
namespace pg8 {
#define PG8_LAS __attribute__((address_space(3)))
typedef unsigned short bf16_t;
typedef short bf16x8 __attribute__((ext_vector_type(8)));
typedef float f32x4 __attribute__((ext_vector_type(4)));
typedef unsigned u32x4 __attribute__((ext_vector_type(4)));
constexpr int BM = 256, BK = 64, HALF = 128, HTB = HALF * BK * 2  , STAGE_BYTES = 8 * HTB, NXCD = 8, WGM = 8;

__host__ __device__ __forceinline__ int lds_byte(int r, int c) { const int st = (r >> 4) * 2 + (c >> 5), rr = r & 15, cc = c & 31, ob = rr * 64 + cc * 2; return st * 1024 + (ob ^ (((ob >> 9) & 1) << 5)); }
__host__ __device__ __forceinline__ void stage_rc(int b, int& R, int& C) { const int st = b / 1024, sb = b % 1024, swz = sb ^ (((sb >> 9) & 1) << 5); R = (st >> 1) * 16 + swz / 64; C = (st & 1) * 32 + (swz % 64) / 2; }
__host__ __device__ __forceinline__ int perm32(int rho) { const int n = rho >> 4, i = rho & 15; return 8 * (i >> 2) + 4 * n + (i & 3); }

struct Unit { int pm, pn; };
struct Gemm { const bf16_t* A; const bf16_t* Bt; int M, N, K, lda; };

struct StaticOrder {
    int nM, nN, nwg, G, c;
    __host__ __device__ void init(int M, int N, int G_, int c_) { nM = M / BM; nN = N / BM; nwg = nM * nN; G = G_; c = c_; }
    __host__ __device__ bool next(int i, Unit& u) const {
        const long L = (long)i * G + c; if (L >= nwg) return false;
        int wgid = (int)L; { const int q = nwg / NXCD, r = nwg % NXCD, xcd = wgid % NXCD, off = wgid / NXCD; wgid = (xcd < r ? xcd * (q + 1) : r * (q + 1) + (xcd - r) * q) + off; }
        const int nig = WGM * nN, gid = wgid / nig, fm = gid * WGM, gsz = (nM - fm) < WGM ? (nM - fm) : WGM;
        u.pm = fm + ((wgid % nig) % gsz); u.pn = (wgid % nig) / gsz; return true;
    }
    __device__ __forceinline__ void a_ready(const Unit&) const {}
    __device__ __forceinline__ void done(const Unit&) const {}
};

__device__ __forceinline__ unsigned cvt_pk_bf16(float lo, float hi) { unsigned r; asm volatile("v_cvt_pk_bf16_f32 %0, %1, %2" : "=v"(r) : "v"(lo), "v"(hi)); return r; }
typedef float f32x2 __attribute__((ext_vector_type(2)));
template <class Epi, class Sched, bool ALIGN_EPI = false, bool SP2 = false>
__device__ __forceinline__ void gemm_phase(PG8_LAS unsigned char* lds, const Gemm g, const Sched& S, const Epi& E, const int tid) {
    const int wid = __builtin_amdgcn_readfirstlane(tid >> 6), lane = tid & 63, wr = wid >> 2, wc = wid & 3, fr = lane & 15, fq = lane >> 4;
    const int K = g.K, nt = K / BK;
    unsigned voffA[2], voffB[2];
#pragma unroll
    for (int i = 0; i < 2; ++i) { int R, C; stage_rc(tid * 16 + i * 8192, R, C); const int Rb = Epi::PERM ? ((R & ~31) + perm32(R & 31)) : R;
        voffA[i] = (unsigned)(R * g.lda + C) * 2u; voffB[i] = (unsigned)(Rb * K + C) * 2u; }
    const size_t kstep = (size_t)(BK * 2);
    const size_t hstepA = (size_t)HALF * g.lda * 2, hstepB = (size_t)HALF * K * 2;
    const size_t tstepA = 2 * hstepA, tstepB = 2 * hstepB;
    const unsigned ldsw = (unsigned)wid * 1024u;
    const int aoff = lds_byte(wr * 64 + fr, fq * 8), boff = lds_byte(wc * 32 + fr, fq * 8);
#define PG8_SA(b, h) (((b) * 2 + (h)) * HTB)
#define PG8_SB(b, h) ((4 + (b) * 2 + (h)) * HTB)
#define PG8_STAGE(bufoff, gbase, voff) do { _Pragma("unroll") for (int _i = 0; _i < 2; ++_i) \
        __builtin_amdgcn_global_load_lds((const unsigned*)((const char*)(gbase) + (voff)[_i]), (PG8_LAS unsigned*)(lds + (bufoff) + ldsw + _i * 8192), 16, 0, 0); } while (0)
#define PG8_LDA(dst, b, h) do { _Pragma("unroll") for (int m = 0; m < 4; ++m) _Pragma("unroll") for (int k = 0; k < 2; ++k) dst[m][k] = *(const PG8_LAS bf16x8*)(lds + PG8_SA(b, h) + aoff + m * 2048 + k * 1024); } while (0)
#define PG8_LDB(dst, b, h) do { _Pragma("unroll") for (int n = 0; n < 2; ++n) _Pragma("unroll") for (int k = 0; k < 2; ++k) dst[n][k] = *(const PG8_LAS bf16x8*)(lds + PG8_SB(b, h) + boff + n * 2048 + k * 1024); } while (0)
#define PG8_MMA(ai, bj, At, Bt) do { __builtin_amdgcn_s_setprio(1); _Pragma("unroll") for (int m = 0; m < 4; ++m) _Pragma("unroll") for (int n = 0; n < 2; ++n) _Pragma("unroll") for (int k = 0; k < 2; ++k) \
        acc[ai][bj][m][n] = __builtin_amdgcn_mfma_f32_16x16x32_bf16(Bt[n][k], At[m][k], acc[ai][bj][m][n], 0, 0, 0); __builtin_amdgcn_s_setprio(0); } while (0)
#define PG8_WAIT_V(n) asm volatile("s_waitcnt vmcnt(" #n ")" ::: "memory")
#define PG8_WAIT_L(n) asm volatile("s_waitcnt lgkmcnt(" #n ")" ::: "memory")
#define PG8_BAR __builtin_amdgcn_s_barrier()
#define PG8_SCHED __builtin_amdgcn_sched_barrier(0)
    Unit cur, nxt; int ui = 0;
    if (!S.next(0, cur)) return;
    f32x4 acc[2][2][4][2];
#pragma unroll
    for (int a = 0; a < 2; ++a)
#pragma unroll
        for (int b = 0; b < 2; ++b)
#pragma unroll
            for (int m = 0; m < 4; ++m)
#pragma unroll
                for (int n = 0; n < 2; ++n) acc[a][b][m][n] = (f32x4){0.f, 0.f, 0.f, 0.f};
    bf16x8 At[4][2], B0[2][2], B1[2][2];
    const char* cA = (const char*)g.A + (size_t)cur.pm * tstepA; const char* cB = (const char*)g.Bt + (size_t)cur.pn * tstepB;
    S.a_ready(cur);
    if constexpr (SP2) {
        PG8_STAGE(PG8_SB(0, 0), cB, voffB); PG8_STAGE(PG8_SB(0, 1), cB + hstepB, voffB); PG8_STAGE(PG8_SA(0, 0), cA, voffA); PG8_STAGE(PG8_SA(0, 1), cA + hstepA, voffA);
        if (wr == 1) PG8_BAR;
        PG8_WAIT_V(2); PG8_BAR;
        PG8_STAGE(PG8_SB(1, 0), cB + kstep, voffB); PG8_STAGE(PG8_SA(1, 0), cA + kstep, voffA); PG8_STAGE(PG8_SB(1, 1), cB + hstepB + kstep, voffB);
        PG8_WAIT_V(6); PG8_BAR;
    } else {
        PG8_STAGE(PG8_SB(0, 0), cB, voffB); PG8_STAGE(PG8_SA(0, 0), cA, voffA); PG8_STAGE(PG8_SB(0, 1), cB + hstepB, voffB); PG8_STAGE(PG8_SA(0, 1), cA + hstepA, voffA);
        if (wr == 1) PG8_BAR;
        PG8_WAIT_V(4); PG8_BAR;
        PG8_STAGE(PG8_SB(1, 0), cB + kstep, voffB); PG8_STAGE(PG8_SA(1, 0), cA + kstep, voffA); PG8_STAGE(PG8_SB(1, 1), cB + hstepB + kstep, voffB);
        PG8_WAIT_V(6); PG8_BAR;
    }
    for (;;) {
        const bool has_next = S.next(ui + 1, nxt);
        const char* nA = has_next ? (const char*)g.A + (size_t)nxt.pm * tstepA : cA; const char* nB = has_next ? (const char*)g.Bt + (size_t)nxt.pn * tstepB : cB;
        for (int t = 0; t < nt; t += 2) {
            const bool last = (t == nt - 2);
            const char* a1 = cA + (size_t)(t + 1) * kstep;
            const char* a2 = last ? nA : cA + (size_t)(t + 2) * kstep; const char* b2 = last ? nB : cB + (size_t)(t + 2) * kstep;
            const char* a3 = a2 + kstep; const char* b3 = b2 + kstep;
            if (last && has_next) S.a_ready(nxt);
            if constexpr (SP2) {
            PG8_LDB(B0, 0, 0); PG8_LDB(B1, 0, 1); PG8_SCHED; PG8_LDA(At, 0, 0); PG8_STAGE(PG8_SA(1, 1), a1 + hstepA, voffA);
            PG8_WAIT_V(8); PG8_WAIT_L(0); PG8_BAR; PG8_MMA(0, 0, At, B0); PG8_MMA(0, 1, At, B1); PG8_BAR; PG8_SCHED;
            PG8_LDA(At, 0, 1); PG8_STAGE(PG8_SB(0, 0), b2, voffB); PG8_STAGE(PG8_SB(0, 1), b2 + hstepB, voffB); PG8_STAGE(PG8_SA(0, 0), a2, voffA);
            PG8_WAIT_V(8); PG8_WAIT_L(0); PG8_BAR; PG8_MMA(1, 0, At, B0); PG8_MMA(1, 1, At, B1); PG8_BAR; PG8_SCHED;
            PG8_LDB(B0, 1, 0); PG8_LDB(B1, 1, 1); PG8_SCHED; PG8_LDA(At, 1, 0); PG8_STAGE(PG8_SA(0, 1), a2 + hstepA, voffA);
            PG8_WAIT_V(8); PG8_WAIT_L(0); PG8_BAR; PG8_MMA(0, 0, At, B0); PG8_MMA(0, 1, At, B1); PG8_BAR; PG8_SCHED;
            PG8_LDA(At, 1, 1); PG8_STAGE(PG8_SB(1, 0), b3, voffB); PG8_STAGE(PG8_SB(1, 1), b3 + hstepB, voffB); PG8_STAGE(PG8_SA(1, 0), a3, voffA);
            PG8_WAIT_V(8); PG8_WAIT_L(0); PG8_BAR; PG8_MMA(1, 0, At, B0); PG8_MMA(1, 1, At, B1); PG8_BAR; PG8_SCHED;
            } else {
            PG8_LDB(B0, 0, 0); PG8_SCHED; PG8_LDA(At, 0, 0); PG8_STAGE(PG8_SA(1, 1), a1 + hstepA, voffA);
            PG8_WAIT_L(8); PG8_BAR; PG8_WAIT_L(0); PG8_MMA(0, 0, At, B0); PG8_BAR; PG8_SCHED;
            PG8_LDB(B1, 0, 1); PG8_STAGE(PG8_SB(0, 0), b2, voffB);
            PG8_BAR; PG8_WAIT_L(0); PG8_MMA(0, 1, At, B1); PG8_BAR;
            PG8_LDA(At, 0, 1); PG8_STAGE(PG8_SA(0, 0), a2, voffA);
            PG8_BAR; PG8_WAIT_L(0); PG8_MMA(1, 0, At, B0); PG8_BAR; PG8_SCHED;
            PG8_STAGE(PG8_SB(0, 1), b2 + hstepB, voffB);
            PG8_WAIT_V(6); PG8_BAR; PG8_MMA(1, 1, At, B1); PG8_BAR;
            PG8_LDB(B0, 1, 0); PG8_SCHED; PG8_LDA(At, 1, 0); PG8_STAGE(PG8_SA(0, 1), a2 + hstepA, voffA);
            PG8_WAIT_L(8); PG8_BAR; PG8_WAIT_L(0); PG8_MMA(0, 0, At, B0); PG8_BAR; PG8_SCHED;
            PG8_LDB(B1, 1, 1); PG8_STAGE(PG8_SB(1, 0), b3, voffB);
            PG8_BAR; PG8_WAIT_L(0); PG8_MMA(0, 1, At, B1); PG8_BAR;
            PG8_LDA(At, 1, 1); PG8_STAGE(PG8_SA(1, 0), a3, voffA);
            PG8_BAR; PG8_WAIT_L(0); PG8_MMA(1, 0, At, B0); PG8_BAR; PG8_SCHED;
            PG8_STAGE(PG8_SB(1, 1), b3 + hstepB, voffB);
            PG8_WAIT_V(6); PG8_BAR; PG8_MMA(1, 1, At, B1); PG8_BAR;
            }
        }
        if constexpr (ALIGN_EPI) { if (wr == 0) PG8_BAR; }
        if constexpr (!Epi::AFTER_DRAIN) { E(acc, cur, wr, wc, fr, fq); S.done(cur); }
        if (!has_next) break;
#pragma unroll
        for (int a = 0; a < 2; ++a)
#pragma unroll
            for (int b = 0; b < 2; ++b)
#pragma unroll
                for (int m = 0; m < 4; ++m)
#pragma unroll
                    for (int n = 0; n < 2; ++n) acc[a][b][m][n] = (f32x4){0.f, 0.f, 0.f, 0.f};
        cur = nxt; cA = nA; cB = nB; ++ui;
        if constexpr (ALIGN_EPI) { if (wr == 1) PG8_BAR; }
    }
    PG8_WAIT_V(0);
    if constexpr (!ALIGN_EPI) { if (wr == 0) PG8_BAR; }
    PG8_BAR;
    if constexpr (Epi::AFTER_DRAIN) { E.fused(acc, cur, wr, wc, fr, fq, lds, wid, lane); S.done(cur); }
#undef PG8_SA
#undef PG8_SB
#undef PG8_STAGE
#undef PG8_LDA
#undef PG8_LDB
#undef PG8_MMA
#undef PG8_WAIT_V
#undef PG8_WAIT_L
#undef PG8_BAR
#undef PG8_SCHED
}
}

#define DI __device__ __forceinline__
#define LAS __attribute__((address_space(3)))
#define GAS __attribute__((address_space(1)))
typedef unsigned short bf16_t;
typedef short bf16x8 __attribute__((ext_vector_type(8)));
typedef short s16x4 __attribute__((ext_vector_type(4)));
typedef float f32x4 __attribute__((ext_vector_type(4)));
typedef float f32x16 __attribute__((ext_vector_type(16)));
typedef unsigned u32x4 __attribute__((ext_vector_type(4)));
typedef unsigned u32x2 __attribute__((ext_vector_type(2)));

constexpr int BATCH = 32, SEQ = 2048, DM = 1024, MTOK = BATCH * SEQ;
constexpr int HALF_B = 16, MH = HALF_B * SEQ;
constexpr int D_IN = 7984, NCAT = 10240, PLD = NCAT + 128;
constexpr int C_RQ = 0, C_RK = 1024, C_RV = 2048, C_RG = 4096, C_NQ = 6144, C_NG = 7936, C_MG = 8192;
constexpr int FF = 4096, PLE = 256;
constexpr float EPS = 1e-6f;
constexpr float LOG2E = 1.4426950408889634f;

constexpr size_t MiB = 1u << 20;
constexpr size_t WS_CTL = 0, CTL_BYTES = 1 * MiB;
constexpr size_t WS_WCAT = 1 * MiB, WS_WRO = 21 * MiB, WS_WNO = 25 * MiB, WS_WOUT = 27 * MiB, WS_WUP = 29 * MiB, WS_WDN = 37 * MiB,
                 WS_WPG = 45 * MiB, WS_WPP = 47 * MiB, WS_WC1K = 48 * MiB, WS_WC1V = 49 * MiB, WS_WC2K = 50 * MiB, WS_WC2V = 50 * MiB + 128 * 1024,
                 WS_CBIAS = 50 * MiB + 512 * 1024, WS_ROPER = 52 * MiB, WS_ROPEN = 84 * MiB, WS_H = 100 * MiB, WS_PB = 228 * MiB,
                 WS_KV = 260 * MiB, WS_CH = 308 * MiB, WS_KCO = 312 * MiB, WS_VCO = 312 * MiB + 512 * 1024, WS_PROJ = 320 * MiB, WS_END = 968 * MiB;
constexpr size_t WS_SS1 = 64 * 1024, WS_SS2 = 64 * 1024 + 256 * 1024;
constexpr size_t KVBUF = 8 * MiB;

constexpr int LDS_BYTES = 147456;

struct Params { const float* in[23]; float* out; unsigned char* ws; };

DI unsigned f2bf(float f) { unsigned u = __builtin_bit_cast(unsigned, f); return (u + 0x7fffu + ((u >> 16) & 1u)) >> 16; }
typedef float f32x2_t __attribute__((ext_vector_type(2))); typedef __bf16 bf16x2_t __attribute__((ext_vector_type(2)));
DI unsigned pk2(float lo, float hi) { f32x2_t v = {lo, hi}; bf16x2_t b = __builtin_convertvector(v, bf16x2_t); return __builtin_bit_cast(unsigned, b); }
DI float bflo(unsigned u) { return __builtin_bit_cast(float, u << 16); }
DI float bfhi(unsigned u) { return __builtin_bit_cast(float, u & 0xffff0000u); }
DI float bf2f(bf16_t h) { return __builtin_bit_cast(float, (unsigned)h << 16); }
DI float shx(float v, int o, int lane) { return __builtin_bit_cast(float, __builtin_amdgcn_ds_bpermute((lane ^ o) << 2, __builtin_bit_cast(int, v))); }
DI unsigned shxu(unsigned v, int o, int lane) { return (unsigned)__builtin_amdgcn_ds_bpermute((lane ^ o) << 2, (int)v); }
DI float wave_sum(float v, int lane) {
#pragma unroll
    for (int o = 1; o < 64; o <<= 1) v += shx(v, o, lane);
    return v;
}
DI int lane_id_asm() { int l; asm volatile("v_mbcnt_lo_u32_b32 %0, -1, 0\n\tv_mbcnt_hi_u32_b32 %0, -1, %0" : "=v"(l)); return l; }
DI int crow(int i, int h) { return (i & 3) + 8 * (i >> 2) + 4 * h; }
#define MFMA32(a, b, c) __builtin_amdgcn_mfma_f32_32x32x16_bf16((a), (b), (c), 0, 0, 0)
template <int S> DI bf16x8 pack8(const f32x16& x) {
    u32x4 p; p[0] = pk2(x[8 * S + 0], x[8 * S + 1]); p[1] = pk2(x[8 * S + 2], x[8 * S + 3]); p[2] = pk2(x[8 * S + 4], x[8 * S + 5]); p[3] = pk2(x[8 * S + 6], x[8 * S + 7]);
    return __builtin_bit_cast(bf16x8, p);
}
DI bf16x8 lds16(LAS unsigned char* p) { return *(LAS bf16x8*)p; }
DI bf16x8 lds8x2(LAS unsigned char* p) {
    const s16x4 lo = *(LAS s16x4*)p, hi = *(LAS s16x4*)(p + 16);
    return __builtin_shufflevector(lo, hi, 0, 1, 2, 3, 4, 5, 6, 7);
}
DI float sigmoidf_(float x) { return __builtin_amdgcn_rcpf(1.0f + __expf(-x)); }
DI float gelu_tanh(float x) { const float u = 0.7978845608028654f * (x + 0.044715f * x * x * x); const float e = __expf(2.0f * u); const float t = 1.0f - 2.0f * __builtin_amdgcn_rcpf(e + 1.0f); return 0.5f * x * (1.0f + t); }

enum { K_CAT = 0, K_CMP1, K_CMP2, K_GATE, K_RES, K_RELU2, K_SIG, K_MULRES };
struct EpiAll {
    static constexpr bool PERM = true, AFTER_DRAIN = false;
    int kind, half, flag, ldf, ldh, ldg;
    const float* fb; float* fo; const bf16_t* hg; bf16_t* ho; unsigned char* ws; const float* gvec; float* ssout;
    DI void operator()(const pg8::f32x4 (&acc)[2][2][4][2], const pg8::Unit& u, int wr, int wc, int fr, int fq) const {
        asm volatile("" : "+v"(fr), "+v"(fq));
        const int row0 = u.pm * 256 + wr * 64 + fr, cb0 = wc * 32 + 8 * fq;
        if (kind == K_CAT) {
            const int pn = u.pn;
            bf16_t* PROJ = (bf16_t*)(ws + WS_PROJ);
            const float2* RR = (const float2*)(ws + WS_ROPER); const float2* RN = (const float2*)(ws + WS_ROPEN);
#pragma unroll
            for (int ai = 0; ai < 2; ++ai)
#pragma unroll
                for (int m = 0; m < 4; ++m) {
                    const int row = row0 + ai * 128 + m * 16; const size_t tok = (size_t)half * MH + row;
#pragma unroll
                    for (int bj = 0; bj < 2; ++bj) {
                        const pg8::f32x4 v0 = acc[ai][bj][m][0], v1 = acc[ai][bj][m][1];
                        float x[8] = {v0[0], v0[1], v0[2], v0[3], v1[0], v1[1], v1[2], v1[3]};
                        const int cb = bj * 128 + cb0; const int col = pn * 256 + cb;
                        int mode = 0; float sc = 1.f; const float2* tab = nullptr;
                        bf16_t* dst = PROJ + (size_t)row * PLD + col;
                        if (pn < 8) { mode = 1; tab = RR + tok * 64 + ((col & 127) >> 1); sc = (pn >= 4) ? 0.08838834764831845f : 1.f; }
                        else if (pn >= 24 && pn < 28) { mode = 1; tab = RN + tok * 32 + ((col & 63) >> 1); sc = 0.125f * LOG2E; }
                        else if (pn >= 28 && pn < 31) {
                            const int lc = cb0, g = lc >> 6, d = lc & 63, bl = row >> 11, t = row & 2047;
                            bf16_t* buf = (bf16_t*)(ws + WS_KV + (size_t)((pn - 28) * 2 + bj) * KVBUF);
                            dst = buf + ((size_t)(bl * 2 + g) * SEQ + t) * 64 + d;
                            if (bj == 0) { mode = 1; tab = RN + tok * 32 + (d >> 1); }
                        } else if (pn >= 31) mode = 2;
                        if (mode == 1) {
                            const f32x4 t0 = *(GAS const f32x4*)tab, t1 = *(GAS const f32x4*)(tab + 2);
                            const float c[4] = {t0[0], t0[2], t1[0], t1[2]}, s[4] = {t0[1], t0[3], t1[1], t1[3]};
#pragma unroll
                            for (int p = 0; p < 4; ++p) { const float a = x[2 * p], b = x[2 * p + 1]; x[2 * p] = (a * c[p] - b * s[p]) * sc; x[2 * p + 1] = (b * c[p] + a * s[p]) * sc; }
                        } else if (mode == 2) {
#pragma unroll
                            for (int p = 0; p < 8; ++p) x[p] = sigmoidf_(x[p]);
                        }
                        u32x4 w; w[0] = pk2(x[0], x[1]); w[1] = pk2(x[2], x[3]); w[2] = pk2(x[4], x[5]); w[3] = pk2(x[6], x[7]);
                        *(GAS u32x4*)dst = w;
                    }
                    asm volatile("" ::: "memory");
                }
            return;
        }
        float cbias[2][8];
#pragma unroll
        for (int bj = 0; bj < 2; ++bj)
#pragma unroll
            for (int p = 0; p < 8; ++p) cbias[bj][p] = 0.f;
        if (kind == K_CMP1) {
#pragma unroll
            for (int bj = 0; bj < 2; ++bj)
#pragma unroll
                for (int p = 0; p < 8; ++p) { float b = 0.f;
                    for (int r = 0; r < 16; ++r) b += ((GAS const float*)fb)[r * 256 + u.pn * 256 + bj * 128 + cb0 + p];
                    cbias[bj][p] = b; asm volatile("" ::: "memory"); }
        }
#pragma unroll
        for (int ai = 0; ai < 2; ++ai)
#pragma unroll
            for (int m = 0; m < 4; ++m) {
                const int row = row0 + ai * 128 + m * 16;
                float ssq[2] = {0.f, 0.f};
                float rs = 1.f;
                if ((kind == K_RELU2 || kind == K_SIG) && fb) rs = rsqrtf(((GAS const float*)fb)[row] * (1.f / DM) + EPS);
#pragma unroll
                for (int bj = 0; bj < 2; ++bj) {
                    const pg8::f32x4 v0 = acc[ai][bj][m][0], v1 = acc[ai][bj][m][1];
                    float x[8] = {v0[0], v0[1], v0[2], v0[3], v1[0], v1[1], v1[2], v1[3]};
                    const int col = u.pn * 256 + bj * 128 + cb0;
                    if (kind == K_RES) {
                        bf16_t* op = ho + (size_t)row * ldh + col;
                        float b[8];
                        if (fb) { const float* bp = fb + (size_t)row * ldf + col; const f32x4 b0 = *(GAS const f32x4*)bp, b1 = *(GAS const f32x4*)(bp + 4);
                            b[0] = b0[0]; b[1] = b0[1]; b[2] = b0[2]; b[3] = b0[3]; b[4] = b1[0]; b[5] = b1[1]; b[6] = b1[2]; b[7] = b1[3]; }
                        else { const u32x4 ow = *(GAS const u32x4*)op;
                            b[0] = bflo(ow[0]); b[1] = bfhi(ow[0]); b[2] = bflo(ow[1]); b[3] = bfhi(ow[1]); b[4] = bflo(ow[2]); b[5] = bfhi(ow[2]); b[6] = bflo(ow[3]); b[7] = bfhi(ow[3]); }
                        float v[8];
#pragma unroll
                        for (int p = 0; p < 8; ++p) v[p] = b[p] + x[p];
                        u32x4 w; w[0] = pk2(v[0], v[1]); w[1] = pk2(v[2], v[3]); w[2] = pk2(v[4], v[5]); w[3] = pk2(v[6], v[7]);
                        *(GAS u32x4*)op = w;
                        ssq[bj] = ((v[0] * v[0] + v[1] * v[1]) + (v[2] * v[2] + v[3] * v[3])) + ((v[4] * v[4] + v[5] * v[5]) + (v[6] * v[6] + v[7] * v[7]));
                        continue;
                    }
                    if (kind == K_MULRES) {
                        bf16_t* op = ho + (size_t)row * ldh + col;
                        const u32x4 gw = *(GAS const u32x4*)(hg + (size_t)row * ldg + col);
                        const u32x4 ow = *(GAS const u32x4*)op;
                        u32x4 w;
                        w[0] = pk2(bflo(ow[0]) + x[0] * bflo(gw[0]), bfhi(ow[0]) + x[1] * bfhi(gw[0])); w[1] = pk2(bflo(ow[1]) + x[2] * bflo(gw[1]), bfhi(ow[1]) + x[3] * bfhi(gw[1]));
                        w[2] = pk2(bflo(ow[2]) + x[4] * bflo(gw[2]), bfhi(ow[2]) + x[5] * bfhi(gw[2])); w[3] = pk2(bflo(ow[3]) + x[6] * bflo(gw[3]), bfhi(ow[3]) + x[7] * bfhi(gw[3]));
                        *(GAS u32x4*)op = w;
                        continue;
                    }
                    bf16_t* dst = ho + (size_t)row * ldh + col;
                    if (kind == K_CMP1) {
#pragma unroll
                        for (int p = 0; p < 8; ++p) x[p] = gelu_tanh(x[p] + cbias[bj][p]);
                    } else if (kind == K_CMP2) {
                        if (col >= 64) continue;
                    } else if (kind == K_GATE) {
                        const u32x4 gw = *(GAS const u32x4*)(hg + (size_t)row * ldg + col);
                        const float gv[8] = {bflo(gw[0]), bfhi(gw[0]), bflo(gw[1]), bfhi(gw[1]), bflo(gw[2]), bfhi(gw[2]), bflo(gw[3]), bfhi(gw[3])};
#pragma unroll
                        for (int p = 0; p < 8; ++p) x[p] *= gv[p];
                        if (flag) { const u32x4 ow = *(GAS const u32x4*)dst;
                            x[0] += bflo(ow[0]); x[1] += bfhi(ow[0]); x[2] += bflo(ow[1]); x[3] += bfhi(ow[1]); x[4] += bflo(ow[2]); x[5] += bfhi(ow[2]); x[6] += bflo(ow[3]); x[7] += bfhi(ow[3]); }
                    } else if (kind == K_RELU2) {
#pragma unroll
                        for (int p = 0; p < 8; ++p) { const float r = fmaxf(x[p] * rs, 0.f); x[p] = r * r; }
                    } else if (kind == K_SIG) {
#pragma unroll
                        for (int p = 0; p < 8; ++p) x[p] = sigmoidf_(x[p] * rs);
                    }
                    u32x4 w; w[0] = pk2(x[0], x[1]); w[1] = pk2(x[2], x[3]); w[2] = pk2(x[4], x[5]); w[3] = pk2(x[6], x[7]);
                    *(GAS u32x4*)dst = w;
                }
                if (kind == K_RES) {
                    float t = ssq[0] + ssq[1];
                    t += shx(t, 16, fr + 16 * fq); t += shx(t, 32, fr + 16 * fq);
                    if (fq == 0) (void)__hip_atomic_fetch_add((GAS float*)ssout + row, t, __ATOMIC_RELAXED, __HIP_MEMORY_SCOPE_AGENT);
                }
                asm volatile("" ::: "memory");
            }
    }
};
#define XB_TMO      128
#define XB_XCNT(j)  (256  + 64 * (j))
#define XB_XSUB(j)  (1280 + 64 * (j))
#define XB_XGEN(j)  (2304 + 64 * (j))
#define XB_TOP      3328
#define XB_TOPGEN   3392
#define XCD_BAR_WORDS 3456
#define XB_SPIN_CAP (1u << 18)

__device__ __forceinline__ unsigned xb_ld(unsigned* p)              { return __hip_atomic_load(p, __ATOMIC_RELAXED, __HIP_MEMORY_SCOPE_AGENT); }
__device__ __forceinline__ unsigned xb_add(unsigned* p, unsigned v) { return __hip_atomic_fetch_add(p, v, __ATOMIC_RELAXED, __HIP_MEMORY_SCOPE_AGENT); }
__device__ __forceinline__ unsigned xb_xcc_id() { return (unsigned)__builtin_amdgcn_s_getreg((3 << 11) | 20) & 0xFu; }
#define XB_SPIN(cond, bar) do { unsigned _sp = 0; while (cond) { __builtin_amdgcn_s_sleep(1); \
    if ((++_sp & 255u) == 0u) { if (xb_ld(&(bar)[XB_TMO])) break; if (_sp > XB_SPIN_CAP) { atomicAdd(&(bar)[XB_TMO], 1u); break; } } } } while (0)

struct XcdBarrier {
    unsigned* bar; unsigned x;
    volatile LAS unsigned* st;
};

__device__ __forceinline__ XcdBarrier xcd_barrier_post(unsigned* bar, volatile LAS unsigned* st) {
    XcdBarrier b; b.bar = bar; b.x = xb_xcc_id(); b.st = st;
    if (threadIdx.x == 0) (void)xb_add(&bar[XB_XCNT(b.x)], 1u);
    return b;
}
__device__ __forceinline__ void xcd_barrier_complete(unsigned* bar, unsigned x, unsigned& nloc, unsigned& nx) {
    const unsigned G = gridDim.x * gridDim.y * gridDim.z;
    unsigned sum, cnt, mine, sp = 0u;
    for (;;) {
        sum = 0u; cnt = 0u; mine = 0u;
#pragma unroll
        for (unsigned j = 0; j < 16; ++j) { const unsigned c = xb_ld(&bar[XB_XCNT(j)]); sum += c; cnt += (c > 0u) ? 1u : 0u; mine = (j == x) ? c : mine; }
        if (sum == G) break;
        __builtin_amdgcn_s_sleep(1);
        if ((++sp & 255u) == 0u) { if (xb_ld(&bar[XB_TMO])) break; if (sp > XB_SPIN_CAP) { atomicAdd(&bar[XB_TMO], 1u); break; } }
    }
    nloc = mine > 0u ? mine : 1u; nx = cnt > 0u ? cnt : 1u;
}

__device__ __forceinline__ void xcd_barrier(const XcdBarrier& b) {
    asm volatile("s_waitcnt vmcnt(0)" ::: "memory");
    __syncthreads();
    if (threadIdx.x == 0) {
        unsigned* bar = b.bar;
        __builtin_amdgcn_s_waitcnt(0);
        unsigned nloc = b.st[0], nx = b.st[1];
        if (nloc == 0u) { xcd_barrier_complete(bar, b.x, nloc, nx); b.st[0] = nloc; b.st[1] = nx; }
        const unsigned old = xb_add(&bar[XB_XSUB(b.x)], 1u);
        const unsigned gen = old / nloc;
        if (old + 1u == (gen + 1u) * nloc) {
            __builtin_amdgcn_fence(__ATOMIC_RELEASE, "agent");
            asm volatile("s_waitcnt vmcnt(0)" ::: "memory");
            const unsigned og = xb_add(&bar[XB_TOP], 1u);
            const unsigned tg = og / nx;
            if (og + 1u == (tg + 1u) * nx) xb_add(&bar[XB_TOPGEN], 1u);
            else XB_SPIN(xb_ld(&bar[XB_TOPGEN]) == tg, bar);
            __builtin_amdgcn_fence(__ATOMIC_ACQUIRE, "agent");
            xb_add(&bar[XB_XGEN(b.x)], 1u);
            asm volatile("s_waitcnt vmcnt(0)" ::: "memory");
        } else {
            XB_SPIN(xb_ld(&bar[XB_XGEN(b.x)]) == gen, bar);
            __builtin_amdgcn_fence(__ATOMIC_ACQUIRE, "agent");
            asm volatile("s_waitcnt vmcnt(0)" ::: "memory");
        }
    }
    __syncthreads();
}


DI int perm_hs(int n, int hs) { const int j = n & (hs - 1); return (n - j) + (j >> 1) + (j & 1) * (hs >> 1); }
template <int CM> DI int colmap(int n) {
    if (CM == 0) return n;
    if (CM == 1) {
        if (n >= D_IN) return -1;
        if (n < 2048) return perm_hs(n, 128);
        if (n >= 6144 && n < 7296) return perm_hs(n, 64);
        if ((n >= 7424 && n < 7552) || (n >= 7680 && n < 7808)) return perm_hs(n, 64);
        return n;
    }
    if (CM == 2) return n < 64 ? perm_hs(n, 64) : -1;
    return n < 64 ? n : -1;
}
template <int KM> DI int kmap(int k) { if (KM == 0) return k; return perm_hs(k, 64); }
template <int CM, int KM> DI void transpose_item(const float* W, int K, int Nsrc, int nblk, bf16_t* WT, int row_off, LAS float* scr, int item, int lane, const float* kscale = nullptr) {
    const int kb = item / nblk, nb = item % nblk, k0 = 64 * kb, n0 = 32 * nb;
    const int nsrc = colmap<CM>(n0 + (lane & 31));
#pragma unroll 8
    for (int i = 0; i < 32; ++i) { const int kk = 2 * i + (lane >> 5); const int ks = kmap<KM>(k0 + kk); scr[kk * 33 + (lane & 31)] = nsrc >= 0 ? W[(size_t)ks * Nsrc + nsrc] * (kscale ? kscale[ks] : 1.f) : 0.f; }
    asm volatile("s_waitcnt lgkmcnt(0)" ::: "memory");
    const int c = lane & 7;
#pragma unroll
    for (int j = 0; j < 4; ++j) { const int n = (lane >> 3) + 8 * j; const LAS float* s = scr + (8 * c) * 33 + n;
        u32x4 o; o[0] = pk2(s[0 * 33], s[1 * 33]); o[1] = pk2(s[2 * 33], s[3 * 33]); o[2] = pk2(s[4 * 33], s[5 * 33]); o[3] = pk2(s[6 * 33], s[7 * 33]);
        *(GAS u32x4*)(WT + (size_t)(row_off + n0 + n) * K + k0 + 8 * c) = o; }
    asm volatile("s_waitcnt lgkmcnt(0)" ::: "memory");
}
DI void rms_row_bf16(const float* xrow, const float* g, bf16_t* orow, int lane) {
    GAS const f32x4* xr = (GAS const f32x4*)xrow + lane; GAS const f32x4* gr = (GAS const f32x4*)g + lane;
    f32x4 v[4]; float s = 0.f;
#pragma unroll
    for (int j = 0; j < 4; ++j) { v[j] = xr[64 * j]; s += (v[j][0] * v[j][0] + v[j][1] * v[j][1]) + (v[j][2] * v[j][2] + v[j][3] * v[j][3]); }
    const float r = rsqrtf(wave_sum(s, lane) * (1.f / DM) + EPS);
    GAS u32x2* o8 = (GAS u32x2*)orow + lane;
#pragma unroll
    for (int j = 0; j < 4; ++j) { const f32x4 gg = gr[64 * j]; u32x2 w; w[0] = pk2(v[j][0] * r * gg[0], v[j][1] * r * gg[1]); w[1] = pk2(v[j][2] * r * gg[2], v[j][3] * r * gg[3]); o8[64 * j] = w; }
}
DI void rms_row_final(const bf16_t* xrow, const float* g, float* orow, int lane) {
    GAS const u32x2* xr = (GAS const u32x2*)xrow + lane; GAS const f32x4* gr = (GAS const f32x4*)g + lane;
    f32x4 v[4]; float s = 0.f;
#pragma unroll
    for (int j = 0; j < 4; ++j) { const u32x2 w = xr[64 * j]; v[j] = (f32x4){bflo(w[0]), bfhi(w[0]), bflo(w[1]), bfhi(w[1])}; s += (v[j][0] * v[j][0] + v[j][1] * v[j][1]) + (v[j][2] * v[j][2] + v[j][3] * v[j][3]); }
    const float r = rsqrtf(wave_sum(s, lane) * (1.f / DM) + EPS);
    GAS f32x4* o = (GAS f32x4*)orow + lane;
#pragma unroll
    for (int j = 0; j < 4; ++j) { const f32x4 gg = gr[64 * j]; o[64 * j] = (f32x4){v[j][0] * r * gg[0], v[j][1] * r * gg[1], v[j][2] * r * gg[2], v[j][3] * r * gg[3]}; }
}

DI void rms_row2_bf16(const float* x0, const float* x1, const float* g, bf16_t* o0, bf16_t* o1, int lane) {
    GAS const f32x4* xa = (GAS const f32x4*)x0 + lane; GAS const f32x4* xb = (GAS const f32x4*)x1 + lane; GAS const f32x4* gr = (GAS const f32x4*)g + lane;
    f32x4 a[4], b[4]; float sa = 0.f, sb = 0.f;
#pragma unroll
    for (int j = 0; j < 4; ++j) { a[j] = __builtin_nontemporal_load(xa + 64 * j); b[j] = __builtin_nontemporal_load(xb + 64 * j); }
#pragma unroll
    for (int j = 0; j < 4; ++j) { sa += (a[j][0] * a[j][0] + a[j][1] * a[j][1]) + (a[j][2] * a[j][2] + a[j][3] * a[j][3]); sb += (b[j][0] * b[j][0] + b[j][1] * b[j][1]) + (b[j][2] * b[j][2] + b[j][3] * b[j][3]); }
    const float ra = rsqrtf(wave_sum(sa, lane) * (1.f / DM) + EPS), rb = rsqrtf(wave_sum(sb, lane) * (1.f / DM) + EPS);
    GAS u32x2* pa = (GAS u32x2*)o0 + lane; GAS u32x2* pb = (GAS u32x2*)o1 + lane;
#pragma unroll
    for (int j = 0; j < 4; ++j) { const f32x4 gg = gr[64 * j]; u32x2 w;
        w[0] = pk2(a[j][0] * ra * gg[0], a[j][1] * ra * gg[1]); w[1] = pk2(a[j][2] * ra * gg[2], a[j][3] * ra * gg[3]); pa[64 * j] = w;
        w[0] = pk2(b[j][0] * rb * gg[0], b[j][1] * rb * gg[1]); w[1] = pk2(b[j][2] * rb * gg[2], b[j][3] * rb * gg[3]); pb[64 * j] = w; }
}
DI void rms_row2_final(const bf16_t* x0, const bf16_t* x1, const float* g, float* o0, float* o1, int lane) {
    GAS const u32x2* xa = (GAS const u32x2*)x0 + lane; GAS const u32x2* xb = (GAS const u32x2*)x1 + lane; GAS const f32x4* gr = (GAS const f32x4*)g + lane;
    u32x2 wa[4], wb[4]; float sa = 0.f, sb = 0.f;
#pragma unroll
    for (int j = 0; j < 4; ++j) { wa[j] = xa[64 * j]; wb[j] = xb[64 * j]; }
    f32x4 a[4], b[4];
#pragma unroll
    for (int j = 0; j < 4; ++j) { a[j] = (f32x4){bflo(wa[j][0]), bfhi(wa[j][0]), bflo(wa[j][1]), bfhi(wa[j][1])}; b[j] = (f32x4){bflo(wb[j][0]), bfhi(wb[j][0]), bflo(wb[j][1]), bfhi(wb[j][1])};
        sa += (a[j][0] * a[j][0] + a[j][1] * a[j][1]) + (a[j][2] * a[j][2] + a[j][3] * a[j][3]); sb += (b[j][0] * b[j][0] + b[j][1] * b[j][1]) + (b[j][2] * b[j][2] + b[j][3] * b[j][3]); }
    const float ra = rsqrtf(wave_sum(sa, lane) * (1.f / DM) + EPS), rb = rsqrtf(wave_sum(sb, lane) * (1.f / DM) + EPS);
    GAS f32x4* pa = (GAS f32x4*)o0 + lane; GAS f32x4* pb = (GAS f32x4*)o1 + lane;
#pragma unroll
    for (int j = 0; j < 4; ++j) { const f32x4 gg = gr[64 * j];
        __builtin_nontemporal_store((f32x4){a[j][0] * ra * gg[0], a[j][1] * ra * gg[1], a[j][2] * ra * gg[2], a[j][3] * ra * gg[3]}, pa + 64 * j);
        __builtin_nontemporal_store((f32x4){b[j][0] * rb * gg[0], b[j][1] * rb * gg[1], b[j][2] * rb * gg[2], b[j][3] * rb * gg[3]}, pb + 64 * j); }
}

DI float2 rope_cs(float ang) { const float rev = ang * 0.15915494309189535f; const float fr = rev - rintf(rev); return make_float2(__builtin_amdgcn_cosf(fr), __builtin_amdgcn_sinf(fr)); }
DI void prologue(const Params& P, unsigned char* ws, LAS unsigned char* lds, int tid, int lane, int wave) {
    LAS float* scr = (LAS float*)(lds + wave * 16384);
    const int gw = blockIdx.x * 8 + wave, NGW = gridDim.x * 8;
    constexpr int I_CAT1 = 16 * 256, I_CAT2 = 16 * 64, I_RO = 32 * 32, I_NO = 16 * 32, I_OUT = 16 * 32, I_UP = 16 * 128, I_DN = 64 * 32, I_PG = 16 * 32, I_PP = 4 * 32,
                  I_C1 = 32 * 8, I_C2 = 4 * 8;
    constexpr int NIT = I_CAT1 + I_CAT2 + I_RO + I_NO + I_OUT + I_UP + I_DN + I_PG + I_PP + 2 * I_C1 + 2 * I_C2;
    for (int it = gw; it < NIT; it += NGW) {
        int r = it;
        if (r < I_CAT1) { transpose_item<1, 0>(P.in[4], 1024, D_IN, 256, (bf16_t*)(ws + WS_WCAT), 0, scr, r, lane); continue; } r -= I_CAT1;
        if (r < I_CAT2) { transpose_item<0, 0>(P.in[14], 1024, 2048, 64, (bf16_t*)(ws + WS_WCAT), 8192, scr, r, lane); continue; } r -= I_CAT2;
        if (r < I_RO) { transpose_item<0, 0>(P.in[6], 2048, 1024, 32, (bf16_t*)(ws + WS_WRO), 0, scr, r, lane); continue; } r -= I_RO;
        if (r < I_NO) { transpose_item<0, 0>(P.in[13], 1024, 1024, 32, (bf16_t*)(ws + WS_WNO), 0, scr, r, lane); continue; } r -= I_NO;
        if (r < I_OUT) { transpose_item<0, 0>(P.in[15], 1024, 1024, 32, (bf16_t*)(ws + WS_WOUT), 0, scr, r, lane); continue; } r -= I_OUT;
        if (r < I_UP) { transpose_item<0, 0>(P.in[17], 1024, 4096, 128, (bf16_t*)(ws + WS_WUP), 0, scr, r, lane, P.in[16]); continue; } r -= I_UP;
        if (r < I_DN) { transpose_item<0, 0>(P.in[18], 4096, 1024, 32, (bf16_t*)(ws + WS_WDN), 0, scr, r, lane); continue; } r -= I_DN;
        if (r < I_PG) { transpose_item<0, 0>(P.in[20], 1024, 1024, 32, (bf16_t*)(ws + WS_WPG), 0, scr, r, lane, P.in[19]); continue; } r -= I_PG;
        if (r < I_PP) { transpose_item<0, 0>(P.in[21], 256, 1024, 32, (bf16_t*)(ws + WS_WPP), 0, scr, r, lane); continue; } r -= I_PP;
        if (r < I_C1) { transpose_item<0, 1>(P.in[8], 2048, 256, 8, (bf16_t*)(ws + WS_WC1K), 0, scr, r, lane); continue; } r -= I_C1;
        if (r < I_C1) { transpose_item<0, 0>(P.in[11], 2048, 256, 8, (bf16_t*)(ws + WS_WC1V), 0, scr, r, lane); continue; } r -= I_C1;
        if (r < I_C2) { transpose_item<2, 0>(P.in[9], 256, 64, 8, (bf16_t*)(ws + WS_WC2K), 0, scr, r, lane); continue; } r -= I_C2;
        transpose_item<3, 0>(P.in[12], 256, 64, 8, (bf16_t*)(ws + WS_WC2V), 0, scr, r, lane);
    }
    for (int m = gw; m < MTOK; m += 2 * NGW) if (m + NGW >= MTOK) rms_row_bf16(P.in[0] + (size_t)m * DM, P.in[3], (bf16_t*)(ws + WS_H) + (size_t)m * DM, lane); else rms_row2_bf16(P.in[0] + (size_t)m * DM, P.in[0] + (size_t)(m + NGW) * DM, P.in[3], (bf16_t*)(ws + WS_H) + (size_t)m * DM, (bf16_t*)(ws + WS_H) + (size_t)(m + NGW) * DM, lane);
    {
        const size_t n4 = (size_t)MTOK * PLE / 4, gt = (size_t)blockIdx.x * 512 + tid, NT = (size_t)gridDim.x * 512;
        const f32x4* src = (const f32x4*)P.in[1]; u32x2* dst = (u32x2*)(ws + WS_PB);
        size_t i = gt;
        for (; i + 7 * NT < n4; i += 8 * NT) { f32x4 v[8];
#pragma unroll
            for (int k = 0; k < 8; ++k) v[k] = src[i + k * NT];
#pragma unroll
            for (int k = 0; k < 8; ++k) { u32x2 w; w[0] = pk2(v[k][0], v[k][1]); w[1] = pk2(v[k][2], v[k][3]); dst[i + k * NT] = w; } }
        for (; i < n4; i += NT) { const f32x4 v = src[i]; u32x2 w; w[0] = pk2(v[0], v[1]); w[1] = pk2(v[2], v[3]); dst[i] = w; }
        const int* pos = (const int*)P.in[2];
        float2* RR = (float2*)(ws + WS_ROPER); float2* RN = (float2*)(ws + WS_ROPEN);
        i = gt;
        for (; i + 7 * NT < (size_t)MTOK * 64; i += 8 * NT) { int pv[8];
#pragma unroll
            for (int k = 0; k < 8; ++k) pv[k] = pos[(i + k * NT) >> 6];
#pragma unroll
            for (int k = 0; k < 8; ++k) { const int fi = (int)((i + k * NT) & 63); const float inv = __builtin_amdgcn_exp2f(-(float)(2 * fi) * (13.287712379549449f / 128.0f)); const float ang = (float)pv[k] * inv; RR[i + k * NT] = rope_cs(ang); } }
        for (; i < (size_t)MTOK * 64; i += NT) { const int tok = (int)(i >> 6), fi = (int)(i & 63);
            const float inv = __builtin_amdgcn_exp2f(-(float)(2 * fi) * (13.287712379549449f / 128.0f)); const float ang = (float)pos[tok] * inv; RR[i] = rope_cs(ang); }
        i = gt;
        for (; i + 7 * NT < (size_t)MTOK * 32; i += 8 * NT) { int pv[8];
#pragma unroll
            for (int k = 0; k < 8; ++k) pv[k] = pos[(i + k * NT) >> 5];
#pragma unroll
            for (int k = 0; k < 8; ++k) { const int fi = (int)((i + k * NT) & 31); const float inv = __builtin_amdgcn_exp2f(-(float)(2 * fi) * (13.287712379549449f / 64.0f)); const float ang = (float)pv[k] * inv; RN[i + k * NT] = rope_cs(ang); } }
        for (; i < (size_t)MTOK * 32; i += NT) { const int tok = (int)(i >> 5), fi = (int)(i & 31);
            const float inv = __builtin_amdgcn_exp2f(-(float)(2 * fi) * (13.287712379549449f / 64.0f)); const float ang = (float)pos[tok] * inv; RN[i] = rope_cs(ang); }
    }
    for (int it = gw; it < 128; it += NGW) {
        const int which = it >> 6, jb = (it >> 4) & 3, kr = it & 15;
        const float* pe = P.in[which ? 10 : 7]; const float* w1 = P.in[which ? 11 : 8];
        float a = 0.f;
        for (int k0 = kr * 128; k0 < kr * 128 + 128; k0 += 16) { float pv[16], wv[16];
#pragma unroll
            for (int k = 0; k < 16; ++k) { pv[k] = pe[k0 + k]; wv[k] = w1[(size_t)(k0 + k) * 256 + jb * 64 + lane]; }
#pragma unroll
            for (int k = 0; k < 16; ++k) a += pv[k] * wv[k]; }
        ((float*)(ws + WS_CBIAS))[(which * 16 + kr) * 256 + jb * 64 + lane] = a;
    }
}

constexpr int RQ_OFF = 0, RK_OFF = 17408, RKT_OFF = 34816, RVT_OFF = 53248, RSN_OFF = 90112, RRED_OFF = 99328;
DI void ret_unit(const Params& P, unsigned char* ws, LAS unsigned char* lds, int bl, int h, int tid, int lane, int w, bool dry) {
    bf16_t* PROJ = (bf16_t*)(ws + WS_PROJ);
    const float* gn = P.in[5];
    const int l31 = lane & 31, hh = lane >> 5;
    const float lg = log2f(1.0f - exp2f(-5.0f - (float)h));
    const float g64 = exp2f(64.0f * lg);
    LAS unsigned char* Qs = lds + RQ_OFF; LAS unsigned char* Ks = lds + RK_OFF; LAS unsigned char* Kts = lds + RKT_OFF; LAS unsigned char* Vts = lds + RVT_OFF; LAS unsigned char* Sn = lds + RSN_OFF;
    LAS float* red = (LAS float*)(lds + RRED_OFF);
    f32x16 R[4];
#pragma unroll
    for (int d = 0; d < 4; ++d)
#pragma unroll
        for (int i = 0; i < 16; ++i) R[d][i] = 0.f;
    const size_t rowbase = (size_t)bl * SEQ;
    const int lrow = tid & 63;
    u32x4 pq[2], pk[2], pv[4];
    {
        const bf16_t* src = PROJ + (rowbase + lrow) * PLD + h * 128;
#pragma unroll
        for (int it = 0; it < 2; ++it) { pq[it] = *(GAS const u32x4*)(PROJ + (rowbase + 4 * w + (lane >> 4) + 32 * it) * PLD + h * 128 + C_RQ + (lane & 15) * 8);     pk[it] = *(GAS const u32x4*)(src + C_RK + (w + 8 * it) * 8); }
        const bf16_t* srcv = PROJ + (rowbase + lrow) * PLD + C_RV + h * 256;
#pragma unroll
        for (int it = 0; it < 4; ++it) pv[it] = *(GAS const u32x4*)(srcv + (w + 8 * it) * 8);
    }
    const float zrow = __builtin_amdgcn_exp2f((float)(63 - lrow) * lg);
#pragma unroll 1
    for (int c = 0; c < 32; ++c) {
        const int t0 = c * 64;
#pragma unroll
        for (int it = 0; it < 2; ++it) {
            const int ch = w + 8 * it;
            *(LAS u32x4*)(Qs + (4 * w + (lane >> 4) + 32 * it) * 272 + (lane & 15) * 16) = pq[it]; *(LAS u32x4*)(Ks + lrow * 272 + ch * 16) = pk[it];
#pragma unroll
            for (int i = 0; i < 4; ++i) {
                const unsigned kz = pk2(bflo(pk[it][i]) * zrow, bfhi(pk[it][i]) * zrow);
                *(LAS bf16_t*)(Kts + (ch * 8 + 2 * i) * 144 + lrow * 2) = (bf16_t)(kz & 0xffffu);
                *(LAS bf16_t*)(Kts + (ch * 8 + 2 * i + 1) * 144 + lrow * 2) = (bf16_t)(kz >> 16);
            }
        }
#pragma unroll
        for (int it = 0; it < 4; ++it) {
            const int ch = w + 8 * it;
#pragma unroll
            for (int i = 0; i < 4; ++i) {
                *(LAS bf16_t*)(Vts + (ch * 8 + 2 * i) * 144 + lrow * 2) = (bf16_t)(pv[it][i] & 0xffffu);
                *(LAS bf16_t*)(Vts + (ch * 8 + 2 * i + 1) * 144 + lrow * 2) = (bf16_t)(pv[it][i] >> 16);
            }
        }
        __syncthreads();
        if (c + 1 < 32) {
            const bf16_t* src = PROJ + (rowbase + t0 + 64 + lrow) * PLD + h * 128;
#pragma unroll
            for (int it = 0; it < 2; ++it) { pq[it] = *(GAS const u32x4*)(PROJ + (rowbase + t0 + 64 + 4 * w + (lane >> 4) + 32 * it) * PLD + h * 128 + C_RQ + (lane & 15) * 8); pk[it] = *(GAS const u32x4*)(src + C_RK + (w + 8 * it) * 8); }
            const bf16_t* srcv = PROJ + (rowbase + t0 + 64 + lrow) * PLD + C_RV + h * 256;
#pragma unroll
            for (int it = 0; it < 4; ++it) pv[it] = *(GAS const u32x4*)(srcv + (w + 8 * it) * 8);
        }
        f32x16 O[2];
#pragma unroll
        for (int nt = 0; nt < 2; ++nt)
#pragma unroll
            for (int i = 0; i < 16; ++i) O[nt][i] = 0.f;
#pragma unroll
        for (int dt = 0; dt < 4; ++dt) {
            const bf16x8 a0 = pack8<0>(R[dt]), a1 = pack8<1>(R[dt]);
#pragma unroll
            for (int nt = 0; nt < 2; ++nt) {
                const bf16x8 b0 = lds8x2(Qs + (32 * nt + l31) * 272 + (32 * dt + 4 * hh) * 2);
                const bf16x8 b1 = lds8x2(Qs + (32 * nt + l31) * 272 + (32 * dt + 16 + 4 * hh) * 2);
                O[nt] = MFMA32(a0, b0, O[nt]); O[nt] = MFMA32(a1, b1, O[nt]);
            }
        }
#pragma unroll
        for (int nt = 0; nt < 2; ++nt) { const float xi = __builtin_amdgcn_exp2f((float)(32 * nt + l31 + 1) * lg);
#pragma unroll
            for (int i = 0; i < 16; ++i) O[nt][i] *= xi; }
        if (w < 4) {
            const int mt = w >> 1, nt = w & 1;
            f32x16 s;
#pragma unroll
            for (int i = 0; i < 16; ++i) s[i] = 0.f;
#pragma unroll
            for (int st = 0; st < 8; ++st) {
                const bf16x8 a = lds16(Ks + (32 * mt + l31) * 272 + (16 * st + 8 * hh) * 2);
                const bf16x8 b = lds16(Qs + (32 * nt + l31) * 272 + (16 * st + 8 * hh) * 2);
                s = MFMA32(a, b, s);
            }
            const int n = 32 * nt + l31;
            int dbase = n - 32 * mt - 4 * hh; asm volatile("" : "+v"(dbase));
#pragma unroll
            for (int i = 0; i < 16; ++i) { const int dl = dbase - ((i & 3) + 8 * (i >> 2)); s[i] = dl >= 0 ? s[i] * __builtin_amdgcn_exp2f((float)dl * lg) : 0.f; }
#pragma unroll
            for (int g = 0; g < 4; ++g) { u32x2 wv; wv[0] = pk2(s[4 * g], s[4 * g + 1]); wv[1] = pk2(s[4 * g + 2], s[4 * g + 3]);
                *(LAS u32x2*)(Sn + n * 144 + (32 * mt + 8 * g + 4 * hh) * 2) = wv; }
        }
        __syncthreads();
#pragma unroll
        for (int d = 0; d < 4; ++d)
#pragma unroll
            for (int i = 0; i < 16; ++i) R[d][i] *= g64;
#pragma unroll
        for (int st = 0; st < 4; ++st) {
            const bf16x8 v = lds16(Vts + (32 * w + l31) * 144 + (16 * st + 8 * hh) * 2);
#pragma unroll
            for (int nt = 0; nt < 2; ++nt) { const bf16x8 b = lds16(Sn + (32 * nt + l31) * 144 + (16 * st + 8 * hh) * 2); O[nt] = MFMA32(v, b, O[nt]); }
#pragma unroll
            for (int dt = 0; dt < 4; ++dt) { const bf16x8 a = lds16(Kts + (32 * dt + l31) * 144 + (16 * st + 8 * hh) * 2); R[dt] = MFMA32(a, v, R[dt]); }
        }
#pragma unroll
        for (int nt = 0; nt < 2; ++nt) {
            float s1 = 0.f, s2 = 0.f;
#pragma unroll
            for (int i = 0; i < 16; ++i) { s1 += O[nt][i]; s2 += O[nt][i] * O[nt][i]; }
            s1 += shx(s1, 32, lane); s2 += shx(s2, 32, lane);
            if (hh == 0) { red[(w * 64 + 32 * nt + l31) * 2] = s1; red[(w * 64 + 32 * nt + l31) * 2 + 1] = s2; }
        }
        __syncthreads();
#pragma unroll
        for (int nt = 0; nt < 2; ++nt) {
            const int n = 32 * nt + l31;
            float S1 = 0.f, S2 = 0.f;
#pragma unroll
            for (int ww = 0; ww < 8; ++ww) { S1 += red[(ww * 64 + n) * 2]; S2 += red[(ww * 64 + n) * 2 + 1]; }
            const float mean = S1 * (1.f / 256.f); const float var = fmaxf(S2 * (1.f / 256.f) - mean * mean, 0.f); const float rstd = rsqrtf(var + EPS);
            bf16_t* rowp = PROJ + (rowbase + t0 + n) * PLD + h * 256;
#pragma unroll
            for (int g = 0; g < 4; ++g) {
                const int e0 = 32 * w + 8 * g + 4 * hh;
                const u32x2 gt = *(GAS const u32x2*)(rowp + C_RG + e0);
                const f32x4 gg = *(GAS const f32x4*)(gn + h * 256 + e0);
                const float gv[4] = {bflo(gt[0]), bfhi(gt[0]), bflo(gt[1]), bfhi(gt[1])};
                float y[4];
#pragma unroll
                for (int k = 0; k < 4; ++k) { const float sl = gv[k] * __builtin_amdgcn_rcpf(1.0f + __expf(-gv[k])); y[k] = (O[nt][4 * g + k] - mean) * rstd * gg[k] * sl; }
                u32x2 wv; wv[0] = pk2(y[0], y[1]); wv[1] = pk2(y[2], y[3]);
                if (!dry) *(GAS u32x2*)(rowp + C_RV + e0) = wv;
            }
        }
    }
}

constexpr int NBUF = 18432, NIG_OFF = 36864, NIL_OFF = 45312, NSEL_OFF = 53760, NUNI_OFF = 54016, NQ_OFF = 54272, NEMIT_OFF = 128000;
DI void gload_kv(const bf16_t* Kg, const bf16_t* Vg, u32x4& rk, u32x4& rv, int w) {
    const int key = lane_id_asm(), ch = w;
    const int tk = w * 64 + key;
    rk = *(GAS const u32x4*)(Kg + tk * 8); rv = *(GAS const u32x4*)(Vg + key * 64 + ch * 8);
}
DI void st_kv(LAS unsigned char* buf, const u32x4& rk, const u32x4& rv, int w) {
    const int key = lane_id_asm(), ch = w;
    LAS unsigned char* Ks = buf; LAS unsigned char* Vts = buf + 9216;
    { const int tk = w * 64 + key; *(LAS u32x4*)(Ks + (tk >> 3) * 144 + (tk & 7) * 16) = rk; }
    const int kpos = (key & ~15) + (key & 3) + 4 * ((key >> 3) & 1) + 8 * ((key >> 2) & 1);
#pragma unroll
    for (int i = 0; i < 4; ++i) {
        *(LAS bf16_t*)(Vts + (ch * 8 + 2 * i) * 144 + kpos * 2) = (bf16_t)(rv[i] & 0xffffu);
        *(LAS bf16_t*)(Vts + (ch * 8 + 2 * i + 1) * 144 + kpos * 2) = (bf16_t)(rv[i] >> 16);
    }
}
DI constexpr bool q_dead(int mode, int kt, int qt) { return (mode == 1 && kt == 1 && qt == 0) || (mode == 2 && kt == 0 && qt == 1); }
DI constexpr bool q_full(int mode, int kt, int qt) { return mode == 0 || (mode == 1 && kt == 0 && qt == 1) || (mode == 2 && kt == 1 && qt == 0); }
template <int MODE, int PASS, bool SEL>
DI void attn_step(LAS unsigned char* lds, LAS unsigned char* buf, LAS unsigned char* Qw, f32x16 (&O)[2][2], float (&m)[2], float (&l)[2], const bool (&selok)[2],
                  int l31, int hh, int cb, int q0, int tile, int lane) {
    LAS unsigned char* Ks = buf; LAS unsigned char* Vts = buf + 9216;
    lane = lane_id_asm(); l31 = lane & 31; hh = lane >> 5;
    f32x16 st[2][2];
#pragma unroll
    for (int kt = 0; kt < 2; ++kt)
#pragma unroll
        for (int qt = 0; qt < 2; ++qt)
#pragma unroll
            for (int i = 0; i < 16; ++i) st[kt][qt][i] = 0.f;
#pragma unroll
    for (int s = 0; s < 4; ++s) {
        const bf16x8 qb0 = lds16(Qw + l31 * 144 + (16 * s + 8 * hh) * 2), qb1 = lds16(Qw + (32 + l31) * 144 + (16 * s + 8 * hh) * 2);
#pragma unroll
        for (int kt = 0; kt < 2; ++kt) {
            const bf16x8 a = lds16(Ks + (32 * kt + l31) * 144 + (16 * s + 8 * hh) * 2);
            if (!q_dead(MODE, kt, 0)) st[kt][0] = MFMA32(a, qb0, st[kt][0]);
            if (!q_dead(MODE, kt, 1)) st[kt][1] = MFMA32(a, qb1, st[kt][1]);
        }
        if (s == 1) asm volatile("" ::: "memory");
    }
    float subv[2] = {0.f, 0.f};
#pragma unroll
    for (int qt = 0; qt < 2; ++qt) {
        const int qrel = 32 * qt + l31;
        if (MODE != 0) {
#pragma unroll
            for (int kt = 0; kt < 2; ++kt)
#pragma unroll
                for (int i = 0; i < 16; ++i) {
                    if (q_dead(MODE, kt, qt) || q_full(MODE, kt, qt)) continue;
                    const int krel = 32 * kt + crow(i, hh);
                    bool ok = true;
                    if (MODE == 1) ok = (krel <= qrel);
                    if (MODE == 2) ok = (krel > qrel);
                    if (MODE == 3) ok = (16 * (cb + krel) + 31 <= q0 + qrel);
                    st[kt][qt][i] = ok ? st[kt][qt][i] : -1e30f;
                }
        }
        if (PASS != 2) {
            float mx = -1e30f;
#pragma unroll
            for (int kt = 0; kt < 2; ++kt)
#pragma unroll
                for (int i = 0; i < 16; ++i) if (!q_dead(MODE, kt, qt)) mx = fmaxf(mx, st[kt][qt][i]);
            mx = fmaxf(mx, shx(mx, 32, lane));
            if (SEL) mx = selok[qt] ? mx : -1e30f;
            const float mold = m[qt];
            const float mnew = fmaxf(mold, mx);
            const float alpha = __builtin_amdgcn_exp2f(mold - mnew);
            m[qt] = mnew;
            subv[qt] = (SEL && !selok[qt]) ? 1e30f : ((mnew > -1e29f) ? mnew : 0.f);
            l[qt] *= alpha;
            if (PASS == 0) {
#pragma unroll
                for (int dt = 0; dt < 2; ++dt)
#pragma unroll
                    for (int i = 0; i < 16; ++i) O[dt][qt][i] *= alpha;
            }
        } else subv[qt] = (m[qt] > -1e29f) ? m[qt] : 0.f;
    }
#pragma unroll
    for (int kt = 0; kt < 2; ++kt) {
#pragma unroll
        for (int qt = 0; qt < 2; ++qt) {
            if (q_dead(MODE, kt, qt)) continue;
            if (PASS != 2) {
                float sum = 0.f;
#pragma unroll
                for (int i = 0; i < 16; ++i) { const float p = __builtin_amdgcn_exp2f(st[kt][qt][i] - subv[qt]); st[kt][qt][i] = p; sum += p; }
                l[qt] += sum;
            } else {
                LAS int* IG = (LAS int*)(lds + NIG_OFF); LAS int* IL = (LAS int*)(lds + NIL_OFF);
                const int qrel = 32 * qt + l31;
#pragma unroll
                for (int i = 0; i < 16; ++i) st[kt][qt][i] = __builtin_amdgcn_exp2f(st[kt][qt][i] - subv[qt]) * l[qt];
#pragma unroll
                for (int g = 0; g < 4; ++g) {
                    const float gs = (st[kt][qt][4 * g] + st[kt][qt][4 * g + 1]) + (st[kt][qt][4 * g + 2] + st[kt][qt][4 * g + 3]);
                    const int cg = 16 * tile + 8 * kt + 2 * g + hh;
                    (void)__hip_atomic_fetch_add(IG + qrel * 33 + cg, (int)(gs * 16777216.0f + 0.5f), __ATOMIC_RELAXED, __HIP_MEMORY_SCOPE_WORKGROUP);
                    (void)__hip_atomic_fetch_add(IL + qrel * 33 + cg, (int)(st[kt][qt][4 * g + 3] * 16777216.0f + 0.5f), __ATOMIC_RELAXED, __HIP_MEMORY_SCOPE_WORKGROUP);
                }
            }
        }
        if (PASS != 1) {
            const bf16x8 p00 = pack8<0>(st[kt][0]), p01 = pack8<0>(st[kt][1]), p10 = pack8<1>(st[kt][0]), p11 = pack8<1>(st[kt][1]);
#pragma unroll
            for (int dt = 0; dt < 2; ++dt) {
                const bf16x8 v0 = lds16(Vts + (32 * dt + l31) * 144 + (32 * kt + 8 * hh) * 2);
                const bf16x8 v1 = lds16(Vts + (32 * dt + l31) * 144 + (32 * kt + 16 + 8 * hh) * 2);
                if (!q_dead(MODE, kt, 0)) { O[dt][0] = MFMA32(v0, p00, O[dt][0]); O[dt][0] = MFMA32(v1, p10, O[dt][0]); }
                if (!q_dead(MODE, kt, 1)) { O[dt][1] = MFMA32(v0, p01, O[dt][1]); O[dt][1] = MFMA32(v1, p11, O[dt][1]); }
            }
        }
    }
}
template <bool ADD> DI void nsa_emit(bf16_t* obase  , const f32x16 (&O)[2][2], const float (&sc)[2], LAS unsigned char* scr  , bool dry) {
    const int ln_ = lane_id_asm(); const int l31 = ln_ & 31, hh = ln_ >> 5, qp = ln_ >> 1, hf = ln_ & 1;
#pragma unroll
    for (int qt = 0; qt < 2; ++qt)
#pragma unroll
        for (int dt = 0; dt < 2; ++dt) {
#pragma unroll
            for (int g = 0; g < 4; ++g) {
                u32x2 wv; wv[0] = pk2(O[dt][qt][4 * g] * sc[qt], O[dt][qt][4 * g + 1] * sc[qt]); wv[1] = pk2(O[dt][qt][4 * g + 2] * sc[qt], O[dt][qt][4 * g + 3] * sc[qt]);
                *(LAS u32x2*)(scr + l31 * 72 + (8 * g + 4 * hh) * 2) = wv;
            }
            asm volatile("s_waitcnt lgkmcnt(0)" ::: "memory");
            u32x2 r[4];
#pragma unroll
            for (int i = 0; i < 4; ++i) r[i] = *(LAS u32x2*)(scr + qp * 72 + hf * 32 + 8 * i);
            asm volatile("s_waitcnt lgkmcnt(0)" ::: "memory");
            GAS u32x4* gp = (GAS u32x4*)(obase + (size_t)(32 * qt + qp) * PLD + 32 * dt + 16 * hf);
            u32x4 w0 = {r[0][0], r[0][1], r[1][0], r[1][1]}, w1 = {r[2][0], r[2][1], r[3][0], r[3][1]};
            if (ADD) {
                const u32x4 o0 = gp[0], o1 = gp[1];
#pragma unroll
                for (int i = 0; i < 4; ++i) { w0[i] = pk2(bflo(w0[i]) + bflo(o0[i]), bfhi(w0[i]) + bfhi(o0[i])); w1[i] = pk2(bflo(w1[i]) + bflo(o1[i]), bfhi(w1[i]) + bfhi(o1[i])); }
            }
            if (!dry) { gp[0] = w0; gp[1] = w1; }
        }
}
DI void zeroO(f32x16 (&O)[2][2]) {
#pragma unroll
    for (int a = 0; a < 2; ++a)
#pragma unroll
        for (int b = 0; b < 2; ++b)
#pragma unroll
            for (int i = 0; i < 16; ++i) O[a][b][i] = 0.f;
}
DI int next_sel(unsigned uni, int j, int qi) {
    const unsigned rest = (j >= 31) ? 0u : (uni >> (j + 1));
    if (!rest) return 64;
    const int n = j + 1 + __builtin_ctz(rest);
    return n <= qi ? n : 64;
}
DI void nsa_unit(const Params& P, unsigned char* ws, LAS unsigned char* lds, int bl, int g, int qi, int tid, int lane, int w, bool dry) {
    bf16_t* PROJ = (bf16_t*)(ws + WS_PROJ);
    const int l31 = lane & 31, hh = lane >> 5, head = g * 8 + w, bg = bl * 2 + g, q0 = qi * 64;
    const size_t rowbase = (size_t)bl * SEQ;
    const bf16_t* KCO = (const bf16_t*)(ws + WS_KCO) + (size_t)bg * 128 * 64; const bf16_t* VCO = (const bf16_t*)(ws + WS_VCO) + (size_t)bg * 128 * 64;
    const bf16_t* KS = (const bf16_t*)(ws + WS_KV + 2 * KVBUF) + (size_t)bg * SEQ * 64; const bf16_t* VS = (const bf16_t*)(ws + WS_KV + 3 * KVBUF) + (size_t)bg * SEQ * 64;
    const bf16_t* KW = (const bf16_t*)(ws + WS_KV + 4 * KVBUF) + (size_t)bg * SEQ * 64; const bf16_t* VW = (const bf16_t*)(ws + WS_KV + 5 * KVBUF) + (size_t)bg * SEQ * 64;
    LAS int* IG = (LAS int*)(lds + NIG_OFF); LAS int* IL = (LAS int*)(lds + NIL_OFF);
    LAS unsigned* SELM = (LAS unsigned*)(lds + NSEL_OFF); LAS unsigned* UNI = (LAS unsigned*)(lds + NUNI_OFF);
    bf16_t* obase = PROJ + (rowbase + q0) * PLD + C_NQ + head * 64;
    LAS unsigned char* Qw = lds + NQ_OFF + w * 9216;
#pragma unroll
    for (int qt = 0; qt < 2; ++qt) {
        const bf16_t* qrow = PROJ + (rowbase + q0 + 32 * qt + l31) * PLD;
#pragma unroll
        for (int s = 0; s < 4; ++s) *(LAS bf16x8*)(Qw + (32 * qt + l31) * 144 + (16 * s + 8 * hh) * 2) = *(GAS const bf16x8*)(qrow + C_NQ + head * 64 + 16 * s + 8 * hh);
    }
#define NSA_GATE(br, qt) bf2f(((GAS const bf16_t*)PROJ)[(rowbase + q0 + 32 * (qt) + l31e) * PLD + C_NG + (br) * 16 + head])
    for (int i = tid; i < 2 * 64 * 33; i += 512) IG[i] = 0;
    if (tid == 0) UNI[0] = 0u;
    f32x16 O[2][2]; float m[2], l[2]; bool selok[2] = {true, true};
    u32x4 rk, rv;
    const int ntile = (1024 + 31 <= q0 + 63) ? 2 : 1;
    m[0] = m[1] = -1e30f; l[0] = l[1] = 0.f;
    for (int tile = 0; tile < ntile; ++tile) { gload_kv(KCO + tile * 4096, VCO + tile * 4096, rk, rv, w); st_kv(lds + tile * NBUF, rk, rv, w); }
    __syncthreads();
    const bool t0full = (16 * 63 + 31 <= q0);
    if (t0full) attn_step<0, 1, false>(lds, lds, Qw, O, m, l, selok, l31, hh, 0, q0, 0, lane);
    else attn_step<3, 1, false>(lds, lds, Qw, O, m, l, selok, l31, hh, 0, q0, 0, lane);
    if (ntile == 2) attn_step<3, 1, false>(lds, lds + NBUF, Qw, O, m, l, selok, l31, hh, 64, q0, 1, lane);
#pragma unroll
    for (int qt = 0; qt < 2; ++qt) { const float lt = l[qt] + shx(l[qt], 32, lane); l[qt] = lt > 0.f ? 1.0f / lt : 0.f; }
    zeroO(O);
    if (t0full) attn_step<0, 2, false>(lds, lds, Qw, O, m, l, selok, l31, hh, 0, q0, 0, lane);
    else attn_step<3, 2, false>(lds, lds, Qw, O, m, l, selok, l31, hh, 0, q0, 0, lane);
    if (ntile == 2) attn_step<3, 2, false>(lds, lds + NBUF, Qw, O, m, l, selok, l31, hh, 64, q0, 1, lane);
    { const int l31e = lane_id_asm() & 31; const float sc[2] = {NSA_GATE(0, 0), NSA_GATE(0, 1)}; nsa_emit<false>(obase, O, sc, lds + NEMIT_OFF + w * 2304, dry); }
    __syncthreads();
    gload_kv(KS, VS, rk, rv, w);
    {
        const int tsel = w * 64 + lane_id_asm(); const int q = tsel >> 3, pp = tsel & 7;
        LAS int* Gq = IG + q * 33; LAS int* Lq = IL + q * 33;
        int sc4[4];
#pragma unroll
        for (int k = 0; k < 4; ++k) { const int n = 4 * pp + k;
            const int imp = Gq[n] + (n > 0 ? Lq[n - 1] : 0);
            const bool forced = (n == 0) || (n == qi) || (n == qi - 1);
            sc4[k] = forced ? 0x7fffffff : (n <= qi ? imp : -1); }
        __syncthreads();
#pragma unroll
        for (int k = 0; k < 4; ++k) Gq[4 * pp + k] = sc4[k];
        __syncthreads();
        int rank[4] = {0, 0, 0, 0};
        for (int n2 = 0; n2 < 32; ++n2) { const int v = Gq[n2];
#pragma unroll
            for (int k = 0; k < 4; ++k) rank[k] += (v > sc4[k] || (v == sc4[k] && n2 < 4 * pp + k)) ? 1 : 0; }
        unsigned bits = 0u;
#pragma unroll
        for (int k = 0; k < 4; ++k) bits |= (rank[k] < 8) ? (1u << (4 * pp + k)) : 0u;
        const int ln = tsel & 63;
        bits |= shxu(bits, 1, ln); bits |= shxu(bits, 2, ln); bits |= shxu(bits, 4, ln);
        if (pp == 0) SELM[q] = bits;
        unsigned u = bits;
        u |= shxu(u, 8, ln); u |= shxu(u, 16, ln); u |= shxu(u, 32, ln);
        if (ln == 0) (void)__hip_atomic_fetch_or(UNI, u, __ATOMIC_RELAXED, __HIP_MEMORY_SCOPE_WORKGROUP);
    }
    st_kv(lds, rk, rv, w);
    __syncthreads();
    const unsigned uni = (unsigned)__builtin_amdgcn_readfirstlane((int)UNI[0]);
    zeroO(O); m[0] = m[1] = -1e30f; l[0] = l[1] = 0.f;
    int b = 0;
    {
        int j = 0;
        while (j < 64) {
            const int nj = next_sel(uni, j, qi);
            if (nj < 64) gload_kv(KS + (size_t)nj * 4096, VS + (size_t)nj * 4096, rk, rv, w);
            else gload_kv(KW + (size_t)(qi >= 8 ? qi - 8 : 0) * 4096, VW + (size_t)(qi >= 8 ? qi - 8 : 0) * 4096, rk, rv, w);
            selok[0] = (SELM[l31] >> j) & 1u; selok[1] = (SELM[32 + l31] >> j) & 1u;
            if (j == qi) attn_step<1, 0, true>(lds, lds + b * NBUF, Qw, O, m, l, selok, l31, hh, 0, q0, 0, lane);
            else attn_step<0, 0, true>(lds, lds + b * NBUF, Qw, O, m, l, selok, l31, hh, 0, q0, 0, lane);
            st_kv(lds + (b ^ 1) * NBUF, rk, rv, w);
            __syncthreads();
            b ^= 1; j = nj;
        }
    }
    { float sc[2]; const int l31e = lane_id_asm() & 31;
#pragma unroll
      for (int qt = 0; qt < 2; ++qt) { const float lt = l[qt] + shx(l[qt], 32, lane); sc[qt] = lt > 0.f ? NSA_GATE(1, qt) / lt : 0.f; }
      nsa_emit<true>(obase, O, sc, lds + NEMIT_OFF + w * 2304, dry); }
    zeroO(O); m[0] = m[1] = -1e30f; l[0] = l[1] = 0.f; selok[0] = selok[1] = true;
    for (int j = (qi >= 8 ? qi - 8 : 0); j <= qi; ++j) {
        if (j < qi) gload_kv(KW + (size_t)(j + 1) * 4096, VW + (size_t)(j + 1) * 4096, rk, rv, w);
        if (j == qi) attn_step<1, 0, false>(lds, lds + b * NBUF, Qw, O, m, l, selok, l31, hh, 0, q0, 0, lane);
        else if (j == qi - 8) attn_step<2, 0, false>(lds, lds + b * NBUF, Qw, O, m, l, selok, l31, hh, 0, q0, 0, lane);
        else attn_step<0, 0, false>(lds, lds + b * NBUF, Qw, O, m, l, selok, l31, hh, 0, q0, 0, lane);
        if (j < qi) st_kv(lds + (b ^ 1) * NBUF, rk, rv, w);
        __syncthreads();
        b ^= 1;
    }
    { float sc[2]; const int l31e = lane_id_asm() & 31;
#pragma unroll
      for (int qt = 0; qt < 2; ++qt) { const float lt = l[qt] + shx(l[qt], 32, lane); sc[qt] = lt > 0.f ? NSA_GATE(2, qt) / lt : 0.f; }
      nsa_emit<true>(obase, O, sc, lds + NEMIT_OFF + w * 2304, dry); }
}


enum { S_PRO = 0, S_GEMM, S_MIX, S_NORM, S_FINAL };
constexpr int NSTEPS = 22;

__global__ void __launch_bounds__(512, 2) fwd_megakernel(Params P) {
    extern __shared__ __attribute__((aligned(16))) unsigned char lds_raw[];
    LAS unsigned char* lds = (LAS unsigned char*)lds_raw;
    cg::grid_group grid = cg::this_grid();
    const int G = gridDim.x;
    const int wave0 = __builtin_amdgcn_readfirstlane((int)threadIdx.x >> 6);
    if (threadIdx.x < 8) ((LAS unsigned*)(lds + LDS_BYTES - 32))[threadIdx.x] = 0u;
    __syncthreads();
    const XcdBarrier xbar = xcd_barrier_post((unsigned*)(P.ws + WS_CTL) + 4096, (volatile LAS unsigned*)(lds + LDS_BYTES - 32));

    if (G > (1 << 30)) grid.sync();
#pragma unroll 1
#ifdef PROBE_DBL_STEP
    for (int step_ = 0; step_ < NSTEPS + 1; ++step_) {
        const int step = (step_ == NSTEPS) ? PROBE_DBL_STEP : step_;
#else
    for (int step = 0; step < NSTEPS; ++step) {
#endif
#define FRESH_TID() int tid = wave0 * 64 + lane_id_asm(); asm volatile("" : "+v"(tid)); const int lane = tid & 63, wave = __builtin_amdgcn_readfirstlane(tid >> 6); (void)lane; (void)wave
        unsigned char* ws = P.ws; asm volatile("" : "+s"(ws));
        bf16_t* PROJ = (bf16_t*)(ws + WS_PROJ);
        bf16_t* Hb = (bf16_t*)(ws + WS_H);
        bf16_t* Ub = (bf16_t*)(ws + WS_PROJ);
        bf16_t* Gb = (bf16_t*)(ws + WS_PROJ);
        int kind = S_GEMM, half = 0, sub = 0, sync_after = 1;
        if (step == 0) kind = S_PRO;
        else if (step <= 14) { half = (step - 1) / 7; sub = (step - 1) % 7; if (sub == 3) kind = S_MIX; if (sub == 4 || sub == 1) sync_after = 0; }
        else { sub = step - 15 + 7; if (step == 15 || step == 18) { kind = S_NORM; sync_after = 0; } if (step == 21) { kind = S_FINAL; sync_after = 0; } }

        half = __builtin_amdgcn_readfirstlane(half); sub = __builtin_amdgcn_readfirstlane(sub); kind = __builtin_amdgcn_readfirstlane(kind);
        if (kind == S_PRO) {
            FRESH_TID();
            prologue(P, ws, lds, tid, lane, wave);
        } else if (kind == S_GEMM) {
            FRESH_TID();
            pg8::Gemm g; EpiAll E; int Gs = G, c = blockIdx.x;
            E.kind = K_CAT; E.half = half; E.flag = 0; E.ldf = DM; E.ldh = 0; E.ldg = 0; E.fb = nullptr; E.fo = nullptr; E.hg = nullptr; E.ho = nullptr; E.ws = ws; E.gvec = nullptr; E.ssout = nullptr;
            g.A = nullptr; g.Bt = nullptr; g.M = 0; g.N = 0; g.K = 0; g.lda = 0;
            switch (sub) {
            case 0:
                g.A = Hb + (size_t)half * MH * DM; g.Bt = (const bf16_t*)(ws + WS_WCAT); g.M = MH; g.N = NCAT; g.K = DM; g.lda = DM; E.kind = K_CAT; break;
            case 1: {
                const int which = (c >= G / 2) ? 1 : 0; Gs = G / 2; c = c - which * (G / 2);
                g.A = (const bf16_t*)(ws + WS_KV + (size_t)which * KVBUF); g.Bt = (const bf16_t*)(ws + (which ? WS_WC1V : WS_WC1K)); g.M = 4096; g.N = 256; g.K = 2048; g.lda = 1024;
                E.kind = K_CMP1; E.fb = (const float*)(ws + WS_CBIAS) + which * 16 * 256; E.ho = (bf16_t*)(ws + WS_CH + (size_t)which * 2 * MiB); E.ldh = 256; break; }
            case 2: {
                const int which = (c >= G / 2) ? 1 : 0; Gs = G / 2; c = c - which * (G / 2);
                g.A = (const bf16_t*)(ws + WS_CH + (size_t)which * 2 * MiB); g.Bt = (const bf16_t*)(ws + (which ? WS_WC2V : WS_WC2K)); g.M = 4096; g.N = 256; g.K = 256; g.lda = 256;
                E.kind = K_CMP2; E.ho = (bf16_t*)(ws + (which ? WS_VCO : WS_KCO)); E.ldh = 64; break; }
            case 4:
                g.A = PROJ + C_RV; g.Bt = (const bf16_t*)(ws + WS_WRO); g.M = MH; g.N = DM; g.K = 2048; g.lda = PLD;
                E.kind = K_GATE; E.flag = 0; E.hg = PROJ + C_MG; E.ldg = PLD; E.ho = PROJ; E.ldh = PLD; break;
            case 5:
                g.A = PROJ + C_NQ; g.Bt = (const bf16_t*)(ws + WS_WNO); g.M = MH; g.N = DM; g.K = DM; g.lda = PLD;
                E.kind = K_GATE; E.flag = 1; E.hg = PROJ + C_MG + DM; E.ldg = PLD; E.ho = PROJ; E.ldh = PLD; break;
            case 6:
                g.A = PROJ; g.Bt = (const bf16_t*)(ws + WS_WOUT); g.M = MH; g.N = DM; g.K = DM; g.lda = PLD;
                E.kind = K_RES; E.fb = P.in[0] + (size_t)half * MH * DM; E.ldf = DM;
                E.ho = Hb + (size_t)half * MH * DM; E.ldh = DM; E.ssout = (float*)(ws + WS_SS1) + (size_t)half * MH; break;
            case 8:
                g.A = Hb; g.Bt = (const bf16_t*)(ws + WS_WUP); g.M = MTOK; g.N = FF; g.K = DM; g.lda = DM; E.kind = K_RELU2; E.ho = Ub; E.ldh = FF; E.fb = (const float*)(ws + WS_SS1); break;
            case 9:
                g.A = Ub; g.Bt = (const bf16_t*)(ws + WS_WDN); g.M = MTOK; g.N = DM; g.K = FF; g.lda = FF; E.kind = K_RES; E.fb = nullptr;
                E.ho = Hb; E.ldh = DM; E.ssout = (float*)(ws + WS_SS2); break;
            case 11:
                g.A = Hb; g.Bt = (const bf16_t*)(ws + WS_WPG); g.M = MTOK; g.N = DM; g.K = DM; g.lda = DM; E.kind = K_SIG; E.ho = Gb; E.ldh = DM; E.fb = (const float*)(ws + WS_SS2); break;
            default:
                g.A = (const bf16_t*)(ws + WS_PB); g.Bt = (const bf16_t*)(ws + WS_WPP); g.M = MTOK; g.N = DM; g.K = PLE; g.lda = PLE;
                E.kind = K_MULRES; E.ho = Hb; E.ldh = DM; E.hg = Gb; E.ldg = DM; break;
            }
#if defined(PROBE_DBL_STEP) && defined(PROBE_HALF_M)
            if (step_ == NSTEPS) g.M >>= 1;
#endif
            pg8::StaticOrder S; S.init(g.M, g.N, Gs, c);
            pg8::gemm_phase<EpiAll, pg8::StaticOrder, true, true>(lds, g, S, E, tid);
            if (sub == 1) {
                __builtin_amdgcn_fence(__ATOMIC_RELEASE, "agent"); __syncthreads(); __builtin_amdgcn_fence(__ATOMIC_ACQUIRE, "agent");
            }
            __syncthreads();
        } else if (kind == S_MIX) {
#ifndef PROBE_MIX_PASSES
#define PROBE_MIX_PASSES 1
#endif
            LAS unsigned* ubox = (LAS unsigned*)(lds + LDS_BYTES - 64);
#pragma unroll 1
            for (int pass = 0; pass < PROBE_MIX_PASSES; ++pass) {
            const bool dry = pass < PROBE_MIX_PASSES - 1;
            unsigned* ctrs = (unsigned*)(ws + WS_CTL) + 512 * (1 + half + 2 * pass);
            if (wave0 * 64 + lane_id_asm() == 0) { ubox[1] = xb_xcc_id() & 7u; ubox[2] = 0u; }
            for (;;) {
                if (wave0 * 64 + lane_id_asm() == 0) {
                    unsigned q = ubox[1], tries = ubox[2], u;
                    for (;;) { u = atomicAdd(ctrs + 64 * q, 1u); if (u < 144u || tries >= 7u) break; q = (q + 1u) & 7u; ++tries; }
                    ubox[1] = q; ubox[2] = tries; ubox[0] = (u < 144u) ? (q * 256u + u) : 0xffffffffu;
                }
                __syncthreads();
                const unsigned uq = ubox[0];
                __syncthreads();
                if (uq == 0xffffffffu) break;
                const unsigned q = uq >> 8, u = uq & 255u;
                int tid2 = wave0 * 64 + lane_id_asm();
                const int lane2 = tid2 & 63, wave2 = __builtin_amdgcn_readfirstlane(tid2 >> 6);
                if (u < 16u) { const unsigned r = q * 16u + u; ret_unit(P, ws, lds, (int)(r >> 3), (int)(r & 7), tid2, lane2, wave2, dry); }
                else { const unsigned v = u - 16u; const unsigned bg = (v & 3u) * 8u + q; nsa_unit(P, ws, lds, (int)(bg >> 1), (int)(bg & 1u), 31 - (int)(v >> 2), tid2, lane2, wave2, dry); }
            }
            if (PROBE_MIX_PASSES > 1) xcd_barrier(xbar);
            }
        } else if (kind == S_NORM) {
        } else {
            FRESH_TID();
            const int gw = blockIdx.x * 8 + wave, NGW = G * 8;
            for (int m = gw; m < MTOK; m += 2 * NGW) if (m + NGW >= MTOK) rms_row_final(Hb + (size_t)m * DM, P.in[22], P.out + (size_t)m * DM, lane); else rms_row2_final(Hb + (size_t)m * DM, Hb + (size_t)(m + NGW) * DM, P.in[22], P.out + (size_t)m * DM, P.out + (size_t)(m + NGW) * DM, lane);
        }
        if (sync_after) { XcdBarrier xb = xbar; asm volatile("" : "+s"(xb.bar)); xcd_barrier(xb); }
#ifdef PROBE_DBL_STEP
        if (step_ == NSTEPS - 1) { XcdBarrier xb = xbar; asm volatile("" : "+s"(xb.bar)); xcd_barrier(xb); }
#endif
#ifdef PROBE_EXTRA_SYNCS
        for (int e = 0; e < PROBE_EXTRA_SYNCS; ++e) xcd_barrier(xbar);
#endif
    }
}

extern "C" void kernel_launch(void* const* d_in, const int* in_sizes, int n_in, void* d_out, int out_size, void* d_ws, size_t ws_size, hipStream_t stream) {
    static int grid = 0;
    if (grid == 0) {
        if (n_in != 23 || ws_size < WS_END) { fprintf(stderr, "kernel_launch: unexpected inputs (n_in %d, ws %zu)\n", n_in, ws_size); grid = -1; return; }
        int dev = 0, cus = 0, per_cu = 0;
        hipGetDevice(&dev); hipDeviceGetAttribute(&cus, hipDeviceAttributeMultiprocessorCount, dev);
        if (hipFuncSetAttribute((const void*)fwd_megakernel, hipFuncAttributeMaxDynamicSharedMemorySize, LDS_BYTES) != hipSuccess) { fprintf(stderr, "kernel_launch: hipFuncSetAttribute failed\n"); grid = -1; return; }
        if (hipOccupancyMaxActiveBlocksPerMultiprocessor(&per_cu, (const void*)fwd_megakernel, 512, LDS_BYTES) != hipSuccess || per_cu < 1) { fprintf(stderr, "kernel_launch: occupancy query gives %d\n", per_cu); per_cu = 1; }
        (void)hipGetLastError();
        grid = cus;
        if (grid > 256) grid = 256;
        if (grid & 1) grid -= 1;
    }
    if (grid < 0) return;
    hipMemsetAsync((char*)d_ws + WS_CTL, 0, CTL_BYTES, stream);
    Params p{};
    for (int i = 0; i < 23; ++i) p.in[i] = (const float*)d_in[i];
    p.out = (float*)d_out; p.ws = (unsigned char*)d_ws;
    void* args[] = {&p};
    hipError_t e = hipLaunchCooperativeKernel((const void*)fwd_megakernel, dim3(grid), dim3(512), args, LDS_BYTES, stream);
    if (e != hipSuccess) fprintf(stderr, "cooperative launch failed: %s (grid %d)\n", hipGetErrorString(e), grid);
}
```
